# Optimizing an MI355X kernel written in HIP

```python
import math
import jax, jax.numpy as jnp
from jax import lax
import numpy as np

D_MODEL = 2048
BATCH = 16
SEQ = 2048
DEPTH = 4

MEM_LEN = 256
XA_HEADS = 4
XA_HEAD_DIM = D_MODEL // XA_HEADS
MIX_WIDTH = D_MODEL
POOL_WIDTH = MIX_WIDTH // 2
POOL_WINDOWS = (2, 4, 8, 16)
POOL_GROUP = POOL_WIDTH // len(POOL_WINDOWS)
DN_HEAD_DIM = 128
DN_WIDTH = MIX_WIDTH - POOL_WIDTH
DN_HEADS = DN_WIDTH // DN_HEAD_DIM
DN_CONV = 4
DN_CHUNK = 64
IN_WIDTH = POOL_WIDTH + 4 * DN_WIDTH + 2 * DN_HEADS
D_FF = 256 * ((8 * D_MODEL // 3 + 255) // 256)
FFN_CONV = 3
EPS = 1e-6

kernel_name = "hybrid_pool_deltanet_memxattn_convglu"


def rms_norm(x, g):
    xf = x.astype(jnp.float32)
    y = xf * lax.rsqrt(jnp.mean(xf * xf, axis=-1, keepdims=True) + EPS)
    return (y * g.astype(jnp.float32)).astype(x.dtype)


def l2_normalize(t):
    return t * lax.rsqrt(jnp.sum(t * t, axis=-1, keepdims=True) + EPS)


def causal_dwconv(x, w, b=None):
    K = w.shape[0]
    S = x.shape[1]
    xp = jnp.pad(x, ((0, 0), (K - 1, 0), (0, 0)))
    y = sum(xp[:, k:k + S] * w[k] for k in range(K))
    if b is not None:
        y = y + b
    return y


def pool_mixer(u, w_pool, pool_scale):
    B, S, _ = u.shape
    uf = u.astype(jnp.float32)
    cs = jnp.pad(jnp.cumsum(uf, axis=1), ((0, 0), (1, 0), (0, 0)))
    pos = jnp.arange(1, S + 1, dtype=jnp.float32)
    groups = []
    for i, w in enumerate(POOL_WINDOWS):
        sl = slice(i * POOL_GROUP, (i + 1) * POOL_GROUP)
        c = cs[:, :, sl]
        lagged = jnp.pad(c, ((0, 0), (w - 1, 0), (0, 0)))[:, :S]
        count = jnp.minimum(pos, float(w))
        mean = (c[:, 1:] - lagged) / count[None, :, None]
        groups.append(mean - uf[:, :, sl])
    mixed = jnp.stack(groups, axis=2).astype(u.dtype)
    y = jnp.einsum('bsng,ngh->bsnh', mixed, w_pool).reshape(B, S, POOL_WIDTH)
    return y * pool_scale


def gated_delta_net(q, k, v, z, b_logit, a_logit, conv_w, a_log, dt_bias, norm_g):
    B, S, _ = q.shape
    H, Dh, C = DN_HEADS, DN_HEAD_DIM, DN_CHUNK
    N = S // C
    f32 = jnp.float32
    qkv = jax.nn.silu(causal_dwconv(jnp.concatenate([q, k, v], axis=-1), conv_w)).astype(f32)
    q, k, v = [t.reshape(B, S, H, Dh) for t in jnp.split(qkv, 3, axis=-1)]
    q = l2_normalize(q) * (Dh ** -0.5)
    k = l2_normalize(k)
    beta = jax.nn.sigmoid(b_logit.astype(f32))
    g = -jnp.exp(a_log.astype(f32)) * jax.nn.softplus(a_logit.astype(f32) + dt_bias.astype(f32))

    def to_chunks(t):
        return t.reshape(B, N, C, H, -1).transpose(0, 3, 1, 2, 4)

    q, k, v = to_chunks(q), to_chunks(k), to_chunks(v)
    beta = to_chunks(beta[..., None])[..., 0]
    gc = jnp.cumsum(to_chunks(g[..., None])[..., 0], axis=-1)
    idx = jnp.arange(C)
    causal = idx[:, None] >= idx[None, :]
    strict = idx[:, None] > idx[None, :]
    decay = jnp.exp(jnp.where(causal, gc[..., :, None] - gc[..., None, :], -jnp.inf))
    kk = jnp.einsum('bhncd,bhnjd->bhncj', k, k)
    l_mat = jnp.where(strict, beta[..., :, None] * kk * decay, 0.0)
    rhs = jnp.concatenate([v * beta[..., None], k * (beta * jnp.exp(gc))[..., None]], axis=-1)
    sol = lax.linalg.triangular_solve(l_mat, rhs, left_side=True, lower=True, unit_diagonal=True)
    u_c, w_c = sol[..., :Dh], sol[..., Dh:]
    attn = jnp.einsum('bhncd,bhnjd->bhncj', q, k) * decay
    q_dec = q * jnp.exp(gc)[..., None]
    k_dec = k * jnp.exp(gc[..., -1:] - gc)[..., None]
    chunk_decay = jnp.exp(gc[..., -1])
    xs = tuple(jnp.moveaxis(t, 2, 0) for t in (u_c, w_c, q_dec, k_dec, attn, chunk_decay))

    def step(state, inp):
        u_i, w_i, qd_i, kd_i, a_i, dec_i = inp
        v_new = u_i - jnp.einsum('bhcd,bhde->bhce', w_i, state)
        o_i = jnp.einsum('bhcd,bhde->bhce', qd_i, state) + jnp.einsum('bhcj,bhje->bhce', a_i, v_new)
        state = state * dec_i[..., None, None] + jnp.einsum('bhcd,bhce->bhde', kd_i, v_new)
        return state, o_i

    _, o = lax.scan(step, jnp.zeros((B, H, Dh, Dh), f32), xs)
    o = o.transpose(1, 0, 3, 2, 4).reshape(B, S, H, Dh)
    o = rms_norm(o, norm_g) * jax.nn.silu(z.astype(f32).reshape(B, S, H, Dh))
    return o.reshape(B, S, DN_WIDTH).astype(z.dtype)


def hybrid_mixer(h, w_in, w_pool, pool_scale, dn_conv_w, dn_a_log, dn_dt_bias, dn_norm_g, w_mix_out):
    p = h @ w_in
    o0 = POOL_WIDTH
    u = p[..., :o0]
    q = p[..., o0:o0 + DN_WIDTH]
    k = p[..., o0 + DN_WIDTH:o0 + 2 * DN_WIDTH]
    v = p[..., o0 + 2 * DN_WIDTH:o0 + 3 * DN_WIDTH]
    z = p[..., o0 + 3 * DN_WIDTH:o0 + 4 * DN_WIDTH]
    o1 = o0 + 4 * DN_WIDTH
    b_logit = p[..., o1:o1 + DN_HEADS]
    a_logit = p[..., o1 + DN_HEADS:o1 + 2 * DN_HEADS]
    y_pool = pool_mixer(u, w_pool, pool_scale)
    y_dn = gated_delta_net(q, k, v, z, b_logit, a_logit, dn_conv_w, dn_a_log, dn_dt_bias, dn_norm_g)
    return jnp.concatenate([y_pool, y_dn], axis=-1) @ w_mix_out


def memory_cross_attention(h, mem_h, w_xq, w_xkv, w_xo):
    B, S, _ = h.shape
    M = mem_h.shape[1]
    q = (h @ w_xq).reshape(B, S, XA_HEADS, XA_HEAD_DIM)
    kv = mem_h @ w_xkv
    k = kv[..., :D_MODEL].reshape(B, M, XA_HEADS, XA_HEAD_DIM)
    v = kv[..., D_MODEL:].reshape(B, M, XA_HEADS, XA_HEAD_DIM)
    s = jnp.einsum('bshd,bmhd->bhsm', q, k).astype(jnp.float32) * (XA_HEAD_DIM ** -0.5)
    pr = jax.nn.softmax(s, axis=-1).astype(v.dtype)
    o = jnp.einsum('bhsm,bmhd->bshd', pr, v).reshape(B, S, D_MODEL)
    return o @ w_xo


def conv_glu_ffn(h, w_gate, w_up, conv_w, conv_b, w_down):
    gate = causal_dwconv(h @ w_gate, conv_w, conv_b)
    return (jax.nn.silu(gate) * (h @ w_up)) @ w_down


def setup_inputs(seed: int = 0) -> dict:
    key = jax.random.key(seed)
    ks = jax.random.split(key, 32)
    f32 = jnp.float32

    def nrm(i, shape, scale):
        return jax.random.normal(ks[i], shape, f32) * scale

    def gain(i, shape):
        return 1.0 + 0.02 * jax.random.normal(ks[i], shape, f32)

    dt = jnp.exp(jax.random.uniform(ks[7], (DEPTH, DN_HEADS), f32) * (math.log(0.1) - math.log(0.001)) + math.log(0.001))
    return {
        "x": nrm(0, (BATCH, SEQ, D_MODEL), 1.0),
        "mem": nrm(1, (BATCH, MEM_LEN, D_MODEL), 1.0),
        "mix_norm_g": gain(2, (DEPTH, D_MODEL)),
        "w_in": nrm(3, (DEPTH, D_MODEL, IN_WIDTH), D_MODEL ** -0.5),
        "w_pool": nrm(4, (DEPTH, len(POOL_WINDOWS), POOL_GROUP, POOL_GROUP), POOL_GROUP ** -0.5),
        "pool_scale": gain(5, (DEPTH, POOL_WIDTH)),
        "dn_conv_w": nrm(6, (DEPTH, DN_CONV, 3 * DN_WIDTH), DN_CONV ** -0.5),
        "dn_a_log": jnp.log(jax.random.uniform(ks[8], (DEPTH, DN_HEADS), f32, 1.0, 16.0)),
        "dn_dt_bias": dt + jnp.log(-jnp.expm1(-dt)),
        "dn_norm_g": gain(9, (DEPTH, DN_HEAD_DIM)),
        "w_mix_out": nrm(10, (DEPTH, MIX_WIDTH, D_MODEL), MIX_WIDTH ** -0.5),
        "xa_norm_g": gain(11, (DEPTH, D_MODEL)),
        "mem_norm_g": gain(12, (D_MODEL,)),
        "w_xq": nrm(13, (DEPTH, D_MODEL, D_MODEL), D_MODEL ** -0.5),
        "w_xkv": nrm(14, (DEPTH, D_MODEL, 2 * D_MODEL), D_MODEL ** -0.5),
        "w_xo": nrm(15, (DEPTH, D_MODEL, D_MODEL), D_MODEL ** -0.5),
        "ffn_norm_g": gain(16, (DEPTH, D_MODEL)),
        "w_gate": nrm(17, (DEPTH, D_MODEL, D_FF), D_MODEL ** -0.5),
        "w_up": nrm(18, (DEPTH, D_MODEL, D_FF), D_MODEL ** -0.5),
        "ffn_conv_w": nrm(19, (DEPTH, FFN_CONV, D_FF), FFN_CONV ** -0.5),
        "ffn_conv_b": nrm(20, (DEPTH, D_FF), 0.01),
        "w_down": nrm(21, (DEPTH, D_FF, D_MODEL), D_FF ** -0.5),
        "final_norm_g": gain(22, (D_MODEL,)),
    }


def reference(x, mem, mix_norm_g, w_in, w_pool, pool_scale, dn_conv_w, dn_a_log, dn_dt_bias, dn_norm_g,
              w_mix_out, xa_norm_g, mem_norm_g, w_xq, w_xkv, w_xo, ffn_norm_g, w_gate, w_up,
              ffn_conv_w, ffn_conv_b, w_down, final_norm_g):
    mem_h = rms_norm(mem, mem_norm_g)
    for l in range(DEPTH):
        x = x + hybrid_mixer(rms_norm(x, mix_norm_g[l]), w_in[l], w_pool[l], pool_scale[l], dn_conv_w[l],
                             dn_a_log[l], dn_dt_bias[l], dn_norm_g[l], w_mix_out[l])
        x = x + memory_cross_attention(rms_norm(x, xa_norm_g[l]), mem_h, w_xq[l], w_xkv[l], w_xo[l])
        x = x + conv_glu_ffn(rms_norm(x, ffn_norm_g[l]), w_gate[l], w_up[l], ffn_conv_w[l], ffn_conv_b[l], w_down[l])
    return rms_norm(x, final_norm_g)
```

```cpp
#include <hip/hip_runtime.h>
#include <cstdio>
#include <cstdint>

#ifndef ONE_LAUNCH
#define ONE_LAUNCH 0
#endif

#define LAS __attribute__((address_space(3)))
#define GAS __attribute__((address_space(1)))
typedef unsigned short bf16_t;
typedef short bf16x8 __attribute__((ext_vector_type(8)));
typedef float f32x4 __attribute__((ext_vector_type(4)));
typedef float f32x2 __attribute__((ext_vector_type(2)));
typedef unsigned u32x4 __attribute__((ext_vector_type(4)));
typedef unsigned u32x2 __attribute__((ext_vector_type(2)));

constexpr int DM = 2048, BATCH = 16, SEQ = 2048, DEPTH = 4, MEM_LEN = 256;
constexpr int M = BATCH * SEQ;
constexpr int MM = BATCH * MEM_LEN;
constexpr int INW = 5136, INW_PAD = 5376, PW = 5120;
constexpr int FF = 5632;
constexpr int NWAVES = 8, NTHR = 512;
constexpr float EPS = 1e-6f;

constexpr size_t MiB = 1u << 20;
constexpr size_t WS_CTL = 0, CTL_ZERO_BYTES = 1 * MiB;
constexpr size_t WS_MEMH = 2 * MiB, WS_KX = 18 * MiB, WS_VT = 34 * MiB;
constexpr size_t WS_WIN = 50 * MiB, WS_WF = 71 * MiB, WS_WMOT = 79 * MiB, WS_WPS = 83 * MiB, WS_WXQ = 84 * MiB, WS_WXKV = 92 * MiB, WS_WXO = 108 * MiB, WS_WGU = 116 * MiB, WS_WD = 160 * MiB;
constexpr size_t WS_LOGIT = 182 * MiB, WS_BETA = 184 * MiB, WS_GDEC = 185 * MiB;
constexpr size_t WS_H = 192 * MiB;
constexpr size_t WS_PBUF = 320 * MiB, WS_QKVN = 640 * MiB, WS_ODN = 832 * MiB;
constexpr size_t WS_XQ = 320 * MiB, WS_SBUF = 448 * MiB, WS_PATT = 576 * MiB, WS_OATT = 640 * MiB;
constexpr size_t WS_G = 320 * MiB, WS_U = 672 * MiB;
constexpr size_t WS_END = 1024 * MiB;
constexpr int CW_BAR = 4096;

__device__ __forceinline__ unsigned cvt_pk_bf16(float lo, float hi) { unsigned r; asm("v_cvt_pk_bf16_f32 %0, %1, %2" : "=v"(r) : "v"(lo), "v"(hi)); return r; }
__device__ __forceinline__ float bflo(unsigned u) { return __uint_as_float(u << 16); }
__device__ __forceinline__ float bfhi(unsigned u) { return __uint_as_float(u & 0xffff0000u); }
__device__ __forceinline__ float wave_sum(float v) {
#pragma unroll
    for (int o = 1; o < 64; o <<= 1) v += __shfl_xor(v, o);
    return v;
}
__device__ __forceinline__ float silu_f(float y) { return y / (1.0f + __expf(-y)); }
#define LDS_WAIT() asm volatile("s_waitcnt lgkmcnt(0)" ::: "memory")

namespace pg8 {
constexpr int BM = 256, BK = 64, HALF = 128, HTB = HALF * BK * 2, STAGE_BYTES = 8 * HTB, NXCD = 8, WGM = 8;
__host__ __device__ __forceinline__ int lds_byte(int r, int c) { const int st = (r >> 4) * 2 + (c >> 5), rr = r & 15, cc = c & 31, ob = rr * 64 + cc * 2; return st * 1024 + (ob ^ (((ob >> 9) & 1) << 5)); }
__host__ __device__ __forceinline__ void stage_rc(int b, int& R, int& C) { const int st = b / 1024, sb = b % 1024, swz = sb ^ (((sb >> 9) & 1) << 5); R = (st >> 1) * 16 + swz / 64; C = (st & 1) * 32 + (swz % 64) / 2; }
__host__ __device__ __forceinline__ int perm32(int rho) { const int n = rho >> 4, i = rho & 15; return 8 * (i >> 2) + 4 * n + (i & 3); }

struct Unit { int pm, pn; };
template <int LDA, int LDB, int KK> struct Gemm { static constexpr int lda = LDA, ldb = LDB, K = KK; };

__device__ __forceinline__ bool tile_of(int i, int G, int c, int nM, int nN, int& pm, int& pn) {
    const int nwg = nM * nN; const long L = (long)i * G + c; if (L >= nwg) return false;
    int wgid = (int)L; { const int q = nwg / NXCD, r = nwg % NXCD, xcd = wgid % NXCD, off = wgid / NXCD; wgid = (xcd < r ? xcd * (q + 1) : r * (q + 1) + (xcd - r) * q) + off; }
    const int nig = WGM * nN, gid = wgid / nig, fm = gid * WGM, gsz = (nM - fm) < WGM ? (nM - fm) : WGM;
    pm = fm + ((wgid % nig) % gsz); pn = (wgid % nig) / gsz; return true;
}

struct EpiBf16 {
    static constexpr bool PERM = true;
    template <class Sched> __device__ __forceinline__ void operator()(const f32x4 (&acc)[2][2][4][2], const Unit& u, const Sched& S, int wr, int wc, int fr, int fq) const {
        const int ldc = S.ldc(u);
        bf16_t* base = (bf16_t*)S.optr(u) + (size_t)(wr * 64 + fr) * ldc + wc * 32 + 8 * fq;
#pragma unroll
        for (int ai = 0; ai < 2; ++ai)
#pragma unroll
            for (int m = 0; m < 4; ++m) { bf16_t* rowp = base + (size_t)(ai * HALF + m * 16) * ldc;
#pragma unroll
                for (int bj = 0; bj < 2; ++bj) { const f32x4 v0 = acc[ai][bj][m][0], v1 = acc[ai][bj][m][1];
                    u32x4 w; w.x = cvt_pk_bf16(v0[0], v0[1]); w.y = cvt_pk_bf16(v0[2], v0[3]); w.z = cvt_pk_bf16(v1[0], v1[1]); w.w = cvt_pk_bf16(v1[2], v1[3]);
                    *(u32x4*)(rowp + bj * HALF) = w; } }
    }
};
struct EpiP {
    static constexpr bool PERM = true;
    float* logit;
    template <class Sched> __device__ __forceinline__ void operator()(const f32x4 (&acc)[2][2][4][2], const Unit& u, const Sched& S, int wr, int wc, int fr, int fq) const {
        if (u.pn < 20) { EpiBf16 e; e(acc, u, S, wr, wc, fr, fq); return; }
        if (wc == 0 && fq < 2) {
#pragma unroll
            for (int ai = 0; ai < 2; ++ai)
#pragma unroll
                for (int m = 0; m < 4; ++m) { float* lp = logit + (size_t)(u.pm * BM + wr * 64 + fr + ai * HALF + m * 16) * 16 + 8 * fq;
                    *(f32x4*)lp = acc[ai][0][m][0]; *(f32x4*)(lp + 4) = acc[ai][0][m][1]; }
        }
    }
};
struct EpiResid {
    static constexpr bool PERM = false;
    const float* base; float* out;
    template <class Sched> __device__ __forceinline__ void operator()(const f32x4 (&acc)[2][2][4][2], const Unit& u, const Sched&, int wr, int wc, int fr, int fq) const {
        const size_t off0 = (size_t)(u.pm * BM + wr * 64 + fr) * DM + u.pn * BM + wc * 32 + 4 * fq;
#pragma unroll
        for (int ai = 0; ai < 2; ++ai)
#pragma unroll
            for (int m = 0; m < 4; ++m) { const size_t off = off0 + (size_t)(ai * HALF + m * 16) * DM;
                f32x4 bs[2][2];
#pragma unroll
                for (int bj = 0; bj < 2; ++bj)
#pragma unroll
                    for (int n = 0; n < 2; ++n) bs[bj][n] = *(const f32x4*)(base + off + bj * HALF + n * 16);
#pragma unroll
                for (int bj = 0; bj < 2; ++bj)
#pragma unroll
                    for (int n = 0; n < 2; ++n) *(f32x4*)(out + off + bj * HALF + n * 16) = bs[bj][n] + acc[ai][bj][m][n];
                asm volatile("" ::: "memory"); }
    }
};
struct EpiF32Scale {
    static constexpr bool PERM = false;
    float scale;
    template <class Sched> __device__ __forceinline__ void operator()(const f32x4 (&acc)[2][2][4][2], const Unit& u, const Sched& S, int wr, int wc, int fr, int fq) const {
        const int ldc = S.ldc(u);
        float* base = (float*)S.optr(u) + (size_t)(wr * 64 + fr) * ldc + wc * 32 + 4 * fq;
#pragma unroll
        for (int ai = 0; ai < 2; ++ai)
#pragma unroll
            for (int m = 0; m < 4; ++m) { float* rowp = base + (size_t)(ai * HALF + m * 16) * ldc;
#pragma unroll
                for (int bj = 0; bj < 2; ++bj)
#pragma unroll
                    for (int n = 0; n < 2; ++n) *(f32x4*)(rowp + bj * HALF + n * 16) = acc[ai][bj][m][n] * scale; }
    }
};

template <class G_, class Epi, class Sched, bool ALIGN_EPI>
__device__ __forceinline__ void gemm_phase(LAS unsigned char* lds, const int tid, const Sched& S, const Epi& E) {
    constexpr G_ g{};
    const int wid = __builtin_amdgcn_readfirstlane(tid >> 6), lane = tid & 63, wr = wid >> 2, wc = wid & 3, fr = lane & 15, fq = lane >> 4;
    constexpr int K = g.K, nt = K / BK;
    unsigned voffA[2], voffB[2];
#pragma unroll
    for (int i = 0; i < 2; ++i) { int R, C; stage_rc(tid * 16 + i * 8192, R, C); const int Rb = Epi::PERM ? ((R & ~31) + perm32(R & 31)) : R;
        voffA[i] = (unsigned)(R * g.lda + C) * 2u; voffB[i] = (unsigned)(Rb * g.ldb + C) * 2u; }
    const size_t kstep = (size_t)(BK * 2);
    const size_t hstepA = (size_t)HALF * g.lda * 2, hstepB = (size_t)HALF * g.ldb * 2;
    const unsigned ldsw = (unsigned)wid * 1024u;
    const int aoff = lds_byte(wr * 64 + fr, fq * 8), boff = lds_byte(wc * 32 + fr, fq * 8);
#define PG8_SA(b, h) (((b) * 2 + (h)) * HTB)
#define PG8_SB(b, h) ((4 + (b) * 2 + (h)) * HTB)
#define PG8_STAGE(bufoff, gbase, voff) do { _Pragma("unroll") for (int _i = 0; _i < 2; ++_i) \
        __builtin_amdgcn_global_load_lds((const unsigned*)((const char*)(gbase) + (voff)[_i]), (LAS unsigned*)(lds + (bufoff) + ldsw + _i * 8192), 16, 0, 0); } while (0)
#define PG8_LDA(dst, b, h) do { _Pragma("unroll") for (int m = 0; m < 4; ++m) _Pragma("unroll") for (int k = 0; k < 2; ++k) dst[m][k] = *(const LAS bf16x8*)(lds + PG8_SA(b, h) + aoff + m * 2048 + k * 1024); } while (0)
#define PG8_LDB(dst, b, h) do { _Pragma("unroll") for (int n = 0; n < 2; ++n) _Pragma("unroll") for (int k = 0; k < 2; ++k) dst[n][k] = *(const LAS bf16x8*)(lds + PG8_SB(b, h) + boff + n * 2048 + k * 1024); } while (0)
#define PG8_MMA(ai, bj, At, Bt) do { __builtin_amdgcn_s_setprio(1); _Pragma("unroll") for (int m = 0; m < 4; ++m) _Pragma("unroll") for (int n = 0; n < 2; ++n) _Pragma("unroll") for (int k = 0; k < 2; ++k) \
        acc[ai][bj][m][n] = __builtin_amdgcn_mfma_f32_16x16x32_bf16(Bt[n][k], At[m][k], acc[ai][bj][m][n], 0, 0, 0); __builtin_amdgcn_s_setprio(0); } while (0)
#define PG8_WAIT_V(n) asm volatile("s_waitcnt vmcnt(" #n ")" ::: "memory")
#define PG8_WAIT_L(n) asm volatile("s_waitcnt lgkmcnt(" #n ")" ::: "memory")
#define PG8_BAR __builtin_amdgcn_s_barrier()
#define PG8_SCHED __builtin_amdgcn_sched_barrier(0)
    Unit cur, nxt; int ui = 0;
    if (!S.next(0, cur)) return;
    f32x4 acc[2][2][4][2];
#pragma unroll
    for (int a = 0; a < 2; ++a)
#pragma unroll
        for (int b = 0; b < 2; ++b)
#pragma unroll
            for (int m = 0; m < 4; ++m)
#pragma unroll
                for (int n = 0; n < 2; ++n) acc[a][b][m][n] = (f32x4){0.f, 0.f, 0.f, 0.f};
    bf16x8 At[4][2], B0[2][2], B1[2][2];
    const char* cA = S.aptr(cur); const char* cB = S.bptr(cur);
    PG8_STAGE(PG8_SB(0, 0), cB, voffB); PG8_STAGE(PG8_SB(0, 1), cB + hstepB, voffB); PG8_STAGE(PG8_SA(0, 0), cA, voffA); PG8_STAGE(PG8_SA(0, 1), cA + hstepA, voffA);
    if (wr == 1) PG8_BAR;
    PG8_WAIT_V(2); PG8_BAR;
    PG8_STAGE(PG8_SB(1, 0), cB + kstep, voffB); PG8_STAGE(PG8_SA(1, 0), cA + kstep, voffA); PG8_STAGE(PG8_SB(1, 1), cB + hstepB + kstep, voffB);
    PG8_WAIT_V(6); PG8_BAR;
    for (;;) {
        const bool has_next = S.next(ui + 1, nxt);
        const char* nA = has_next ? S.aptr(nxt) : cA; const char* nB = has_next ? S.bptr(nxt) : cB;
#pragma unroll 1
        for (int t = 0; t < nt; t += 2) {
            const bool last = (t == nt - 2);
            const char* a1 = cA + (size_t)(t + 1) * kstep;
            const char* a2 = last ? nA : cA + (size_t)(t + 2) * kstep; const char* b2 = last ? nB : cB + (size_t)(t + 2) * kstep;
            const char* a3 = a2 + kstep; const char* b3 = b2 + kstep;
            PG8_LDB(B0, 0, 0); PG8_LDB(B1, 0, 1); PG8_SCHED; PG8_LDA(At, 0, 0); PG8_STAGE(PG8_SA(1, 1), a1 + hstepA, voffA);
            PG8_WAIT_V(8); PG8_WAIT_L(0); PG8_BAR; PG8_MMA(0, 0, At, B0); PG8_MMA(0, 1, At, B1); PG8_BAR; PG8_SCHED;
            PG8_LDA(At, 0, 1); PG8_STAGE(PG8_SB(0, 0), b2, voffB); PG8_STAGE(PG8_SB(0, 1), b2 + hstepB, voffB); PG8_STAGE(PG8_SA(0, 0), a2, voffA);
            PG8_WAIT_V(8); PG8_WAIT_L(0); PG8_BAR; PG8_MMA(1, 0, At, B0); PG8_MMA(1, 1, At, B1); PG8_BAR; PG8_SCHED;
            PG8_LDB(B0, 1, 0); PG8_LDB(B1, 1, 1); PG8_SCHED; PG8_LDA(At, 1, 0); PG8_STAGE(PG8_SA(0, 1), a2 + hstepA, voffA);
            PG8_WAIT_V(8); PG8_WAIT_L(0); PG8_BAR; PG8_MMA(0, 0, At, B0); PG8_MMA(0, 1, At, B1); PG8_BAR; PG8_SCHED;
            PG8_LDA(At, 1, 1); PG8_STAGE(PG8_SB(1, 0), b3, voffB); PG8_STAGE(PG8_SB(1, 1), b3 + hstepB, voffB); PG8_STAGE(PG8_SA(1, 0), a3, voffA);
            PG8_WAIT_V(8); PG8_WAIT_L(0); PG8_BAR; PG8_MMA(1, 0, At, B0); PG8_MMA(1, 1, At, B1); PG8_BAR; PG8_SCHED;
        }
        if constexpr (ALIGN_EPI) { if (wr == 0) PG8_BAR; }
        E(acc, cur, S, wr, wc, fr, fq);
        if (!has_next) break;
#pragma unroll
        for (int a = 0; a < 2; ++a)
#pragma unroll
            for (int b = 0; b < 2; ++b)
#pragma unroll
                for (int m = 0; m < 4; ++m)
#pragma unroll
                    for (int n = 0; n < 2; ++n) acc[a][b][m][n] = (f32x4){0.f, 0.f, 0.f, 0.f};
        cur = nxt; cA = nA; cB = nB; ++ui;
        if constexpr (ALIGN_EPI) { if (wr == 1) PG8_BAR; }
    }
    PG8_WAIT_V(0);
    if constexpr (!ALIGN_EPI) { if (wr == 0) PG8_BAR; }
    PG8_BAR;
#undef PG8_SA
#undef PG8_SB
#undef PG8_STAGE
#undef PG8_LDA
#undef PG8_LDB
#undef PG8_MMA
#undef PG8_WAIT_V
#undef PG8_WAIT_L
#undef PG8_BAR
#undef PG8_SCHED
}
}

#define XB_TMO      128
#define XB_XCNT(j)  (256  + 64 * (j))
#define XB_XSUB(j)  (1280 + 64 * (j))
#define XB_XGEN(j)  (2304 + 64 * (j))
#define XB_TOP      3328
#define XB_TOPGEN   3392
#define XCD_BAR_WORDS 3456
#define XB_SPIN_CAP (1u << 18)
__device__ __forceinline__ unsigned xb_ld(unsigned* p)              { return __hip_atomic_load(p, __ATOMIC_RELAXED, __HIP_MEMORY_SCOPE_AGENT); }
__device__ __forceinline__ unsigned xb_add(unsigned* p, unsigned v) { return __hip_atomic_fetch_add(p, v, __ATOMIC_RELAXED, __HIP_MEMORY_SCOPE_AGENT); }
__device__ __forceinline__ unsigned xb_xcc_id() { return (unsigned)__builtin_amdgcn_s_getreg((3 << 11) | 20) & 0xFu; }
#define XB_SPIN(cond, bar) do { unsigned _sp = 0; while (cond) { __builtin_amdgcn_s_sleep(1); \
    if ((++_sp & 255u) == 0u) { if (xb_ld(&(bar)[XB_TMO])) break; if (_sp > XB_SPIN_CAP) { atomicAdd(&(bar)[XB_TMO], 1u); break; } } } } while (0)
struct XcdBarrier { unsigned* bar; unsigned x; volatile LAS unsigned* st; };
__device__ __forceinline__ XcdBarrier xcd_barrier_post(unsigned* bar, volatile LAS unsigned* st) {
    XcdBarrier b; b.bar = bar; b.x = xb_xcc_id(); b.st = st;
    if (threadIdx.x == 0) (void)xb_add(&bar[XB_XCNT(b.x)], 1u);
    return b;
}
__device__ __forceinline__ void xcd_barrier_complete(unsigned* bar, unsigned x, unsigned& nloc, unsigned& nx) {
    const unsigned G = gridDim.x * gridDim.y * gridDim.z;
    unsigned sum, cnt, mine, sp = 0u;
    for (;;) {
        sum = 0u; cnt = 0u; mine = 0u;
#pragma unroll
        for (unsigned j = 0; j < 16; ++j) { const unsigned c = xb_ld(&bar[XB_XCNT(j)]); sum += c; cnt += (c > 0u) ? 1u : 0u; mine = (j == x) ? c : mine; }
        if (sum == G) break;
        __builtin_amdgcn_s_sleep(1);
        if ((++sp & 255u) == 0u) { if (xb_ld(&bar[XB_TMO])) break; if (sp > XB_SPIN_CAP) { atomicAdd(&bar[XB_TMO], 1u); break; } }
    }
    nloc = mine > 0u ? mine : 1u; nx = cnt > 0u ? cnt : 1u;
}
__device__ __forceinline__ void xcd_barrier(const XcdBarrier& b) {
    asm volatile("s_waitcnt vmcnt(0)" ::: "memory");
    __syncthreads();
    if (threadIdx.x == 0) {
        unsigned* bar = b.bar;
        __builtin_amdgcn_s_waitcnt(0);
        unsigned nloc = b.st[0], nx = b.st[1];
        if (nloc == 0u) { xcd_barrier_complete(bar, b.x, nloc, nx); b.st[0] = nloc; b.st[1] = nx; }
        const unsigned old = xb_add(&bar[XB_XSUB(b.x)], 1u);
        const unsigned gen = old / nloc;
        if (old + 1u == (gen + 1u) * nloc) {
            __builtin_amdgcn_fence(__ATOMIC_RELEASE, "agent");
            asm volatile("s_waitcnt vmcnt(0)" ::: "memory");
            const unsigned og = xb_add(&bar[XB_TOP], 1u);
            const unsigned tg = og / nx;
            if (og + 1u == (tg + 1u) * nx) xb_add(&bar[XB_TOPGEN], 1u);
            else XB_SPIN(xb_ld(&bar[XB_TOPGEN]) == tg, bar);
            __builtin_amdgcn_fence(__ATOMIC_ACQUIRE, "agent");
            xb_add(&bar[XB_XGEN(b.x)], 1u);
            asm volatile("s_waitcnt vmcnt(0)" ::: "memory");
        } else {
            XB_SPIN(xb_ld(&bar[XB_XGEN(b.x)]) == gen, bar);
            __builtin_amdgcn_fence(__ATOMIC_ACQUIRE, "agent");
            asm volatile("s_waitcnt vmcnt(0)" ::: "memory");
        }
    }
    __syncthreads();
}

constexpr int RING_OFF = 0, RING_BYTES = 131072;
constexpr int LDSCTL_OFF = RING_BYTES, MISC_OFF = LDSCTL_OFF + 320;
constexpr int LDS_BYTES = 147456;

using pg8::Unit;
template <int NM, int NN, int LDC, int OSZ, size_t ASTEP, size_t BSTEP>
struct SchedStd {
    int G, c; const char* A; const char* B; char* O;
    __device__ __forceinline__ bool next(int i, Unit& u) const { return pg8::tile_of(i, G, c, NM, NN, u.pm, u.pn); }
    __device__ __forceinline__ const char* aptr(const Unit& u) const { return A + (size_t)u.pm * ASTEP; }
    __device__ __forceinline__ const char* bptr(const Unit& u) const { return B + (size_t)u.pn * BSTEP; }
    __device__ __forceinline__ char* optr(const Unit& u) const { return O + ((size_t)u.pm * 256 * LDC + (size_t)u.pn * 256) * OSZ; }
    __device__ __forceinline__ int ldc(const Unit&) const { return LDC; }
};
struct SchedGU {
    int G, c; const char* A; const char* B; char* Gb; char* Ub;
    __device__ __forceinline__ bool next(int i, Unit& u) const { return pg8::tile_of(i, G, c, M / 256, 44, u.pm, u.pn); }
    __device__ __forceinline__ const char* aptr(const Unit& u) const { return A + (size_t)u.pm * 256 * DM * 2; }
    __device__ __forceinline__ const char* bptr(const Unit& u) const { return B + (size_t)u.pn * 256 * DM * 2; }
    __device__ __forceinline__ char* optr(const Unit& u) const { char* ob = u.pn < 22 ? Gb : Ub; const int pc = u.pn < 22 ? u.pn : u.pn - 22; return ob + ((size_t)u.pm * 256 * FF + (size_t)pc * 256) * 2; }
    __device__ __forceinline__ int ldc(const Unit&) const { return FF; }
};
struct SchedS {
    int G, c; const char* XQ; const char* KX; char* SB;
    __device__ __forceinline__ bool next(int i, Unit& u) const { return pg8::tile_of(i, G, c, M / 256, 4, u.pm, u.pn); }
    __device__ __forceinline__ const char* aptr(const Unit& u) const { return XQ + ((size_t)u.pm * 256 * DM + (size_t)u.pn * 512) * 2; }
    __device__ __forceinline__ const char* bptr(const Unit& u) const { return KX + ((size_t)(u.pm / 8) * 256 * DM + (size_t)u.pn * 512) * 2; }
    __device__ __forceinline__ char* optr(const Unit& u) const { return SB + ((size_t)u.pm * 256 * 1024 + (size_t)u.pn * 256) * 4; }
    __device__ __forceinline__ int ldc(const Unit&) const { return 1024; }
};
struct SchedPV {
    int G, c; const char* P; const char* VT; char* O;
    __device__ __forceinline__ bool next(int i, Unit& u) const { return pg8::tile_of(i, G, c, M / 256, 8, u.pm, u.pn); }
    __device__ __forceinline__ const char* aptr(const Unit& u) const { return P + ((size_t)u.pm * 256 * 1024 + (size_t)(u.pn / 2) * 256) * 2; }
    __device__ __forceinline__ const char* bptr(const Unit& u) const { return VT + ((size_t)(u.pm / 8) * 2048 + (size_t)u.pn * 256) * 256 * 2; }
    __device__ __forceinline__ char* optr(const Unit& u) const { return O + ((size_t)u.pm * 256 * DM + (size_t)u.pn * 256) * 2; }
    __device__ __forceinline__ int ldc(const Unit&) const { return DM; }
};
struct SchedKV {
    int G, c; const char* MEMH; const char* W; char* KX; char* VT;
    __device__ __forceinline__ bool next(int i, Unit& u) const { const int id = i * G + c; if (id >= 256) return false; u.pm = id >> 3; u.pn = id & 7; return true; }
    __device__ __forceinline__ const char* aptr(const Unit& u) const { return u.pm < 16 ? MEMH + (size_t)u.pm * 256 * DM * 2 : W + (size_t)(2048 + u.pn * 256) * DM * 2; }
    __device__ __forceinline__ const char* bptr(const Unit& u) const { return u.pm < 16 ? W + (size_t)u.pn * 256 * DM * 2 : MEMH + (size_t)(u.pm - 16) * 256 * DM * 2; }
    __device__ __forceinline__ char* optr(const Unit& u) const { return u.pm < 16 ? KX + ((size_t)u.pm * 256 * DM + (size_t)u.pn * 256) * 2 : VT + ((size_t)(u.pm - 16) * 2048 + (size_t)u.pn * 256) * 256 * 2; }
    __device__ __forceinline__ int ldc(const Unit& u) const { return u.pm < 16 ? DM : 256; }
};
struct SchedWf {
    int G, c; const char* WMOT; const char* WPS; char* WF;
    __device__ __forceinline__ bool next(int i, Unit& u) const { const int id = i * G + c; if (id >= 32) return false; u.pn = id >> 3; u.pm = id & 7; return true; }
    __device__ __forceinline__ const char* aptr(const Unit& u) const { return WMOT + ((size_t)u.pm * 256 * 1024 + (size_t)u.pn * 256) * 2; }
    __device__ __forceinline__ const char* bptr(const Unit& u) const { return WPS + (size_t)u.pn * 65536 * 2; }
    __device__ __forceinline__ char* optr(const Unit& u) const { return WF + ((size_t)u.pm * 256 * DM + (size_t)u.pn * 256) * 2; }
    __device__ __forceinline__ int ldc(const Unit&) const { return DM; }
};
struct SchedP {
    int G, c; const char* A; const char* B; char* PB;
    __device__ __forceinline__ bool next(int i, Unit& u) const { return pg8::tile_of(i, G, c, M / 256, 21, u.pm, u.pn); }
    __device__ __forceinline__ const char* aptr(const Unit& u) const { return A + (size_t)u.pm * 256 * DM * 2; }
    __device__ __forceinline__ const char* bptr(const Unit& u) const { return B + (size_t)u.pn * 256 * DM * 2; }
    __device__ __forceinline__ char* optr(const Unit& u) const { return PB + ((size_t)u.pm * 256 * PW + (size_t)u.pn * 256) * 2; }
    __device__ __forceinline__ int ldc(const Unit&) const { return PW; }
};

typedef SchedStd<M / 256, 8, DM, 4, (size_t)256 * DM * 2, (size_t)256 * DM * 2> SchedX;
typedef SchedStd<M / 256, 8, DM, 2, (size_t)256 * DM * 2, (size_t)256 * DM * 2> SchedQ;
typedef SchedStd<M / 256, 8, DM, 4, (size_t)256 * FF * 2, (size_t)256 * FF * 2> SchedD;

struct Ctx { LAS unsigned char* lds; int tid, lane, wave, gw, NGW; };

__device__ __forceinline__ void transpose_item(const float* W, int K, int N, int ldw, bf16_t* WT, int ldt, LAS float* scr, int item, int lane) {
    const int nblk = (N + 31) / 32, kb = item / nblk, nb = item % nblk, k0 = 64 * kb, n0 = 32 * nb;
    const bool nok = (n0 + (lane & 31)) < N;
#pragma unroll 8
    for (int i = 0; i < 32; ++i) { const int kk = 2 * i + (lane >> 5); scr[kk * 33 + (lane & 31)] = nok ? W[(size_t)(k0 + kk) * ldw + n0 + (lane & 31)] : 0.f; }
    LDS_WAIT(); asm volatile("" ::: "memory");
    const int c = lane & 7;
#pragma unroll
    for (int j = 0; j < 4; ++j) { const int n = (lane >> 3) + 8 * j; const LAS float* s = scr + (8 * c) * 33 + n;
        u32x4 o; o.x = cvt_pk_bf16(s[0 * 33], s[1 * 33]); o.y = cvt_pk_bf16(s[2 * 33], s[3 * 33]); o.z = cvt_pk_bf16(s[4 * 33], s[5 * 33]); o.w = cvt_pk_bf16(s[6 * 33], s[7 * 33]);
        if (n0 + n < N) *(u32x4*)(WT + (size_t)(n0 + n) * ldt + k0 + 8 * c) = o; }
    LDS_WAIT(); asm volatile("" ::: "memory");
}

__device__ __forceinline__ void rmsnorm_rows_bf16(const Ctx& C, const float* x, const float* gain, bf16_t* dst, int nrows) {
    f32x4 gv[8];
#pragma unroll
    for (int j = 0; j < 8; ++j) gv[j] = *(const f32x4*)(gain + (C.lane + 64 * j) * 4);
    for (int m = C.gw; m < nrows; m += C.NGW) {
        const f32x4* xr = (const f32x4*)(x + (size_t)m * DM) + C.lane;
        f32x4 v[8]; float s = 0.f;
#pragma unroll
        for (int j = 0; j < 8; ++j) { v[j] = xr[64 * j]; s += (v[j][0] * v[j][0] + v[j][1] * v[j][1]) + (v[j][2] * v[j][2] + v[j][3] * v[j][3]); }
        const float rstd = rsqrtf(wave_sum(s) * (1.f / DM) + EPS);
        u32x2* o8 = (u32x2*)(dst + (size_t)m * DM) + C.lane;
#pragma unroll
        for (int j = 0; j < 8; ++j) { u32x2 w; w.x = cvt_pk_bf16(v[j][0] * rstd * gv[j][0], v[j][1] * rstd * gv[j][1]); w.y = cvt_pk_bf16(v[j][2] * rstd * gv[j][2], v[j][3] * rstd * gv[j][3]); o8[64 * j] = w; }
    }
}
__device__ __forceinline__ void rmsnorm_rows_f32(const Ctx& C, float* x, const float* gain, int nrows) {
    f32x4 gv[8];
#pragma unroll
    for (int j = 0; j < 8; ++j) gv[j] = *(const f32x4*)(gain + (C.lane + 64 * j) * 4);
    for (int m = C.gw; m < nrows; m += C.NGW) {
        f32x4* xr = (f32x4*)(x + (size_t)m * DM) + C.lane;
        f32x4 v[8]; float s = 0.f;
#pragma unroll
        for (int j = 0; j < 8; ++j) { v[j] = xr[64 * j]; s += (v[j][0] * v[j][0] + v[j][1] * v[j][1]) + (v[j][2] * v[j][2] + v[j][3] * v[j][3]); }
        const float rstd = rsqrtf(wave_sum(s) * (1.f / DM) + EPS);
#pragma unroll
        for (int j = 0; j < 8; ++j) xr[64 * j] = v[j] * rstd * gv[j];
    }
}


#define PHASE_BEGIN() unsigned char* wsl = ws; int bx = bx0; int G = G0; long zoff = 0; Ctx C = C0; asm volatile("" : "+s"(wsl), "+s"(bx), "+s"(G), "+s"(zoff)); C.lane = (int)__builtin_amdgcn_mbcnt_hi(~0u, __builtin_amdgcn_mbcnt_lo(~0u, 0u)); asm volatile("" : "+v"(C.lane)); C.tid = C.wave * 64 + C.lane
#define INP(k) (a.in[k] + zoff)
#define Xl (a.out + zoff)
#define MEMH ((bf16_t*)(wsl + WS_MEMH))
#define KX ((bf16_t*)(wsl + WS_KX))
#define VT ((bf16_t*)(wsl + WS_VT))
#define WinT ((bf16_t*)(wsl + WS_WIN))
#define WfT ((bf16_t*)(wsl + WS_WF))
#define WmoT ((bf16_t*)(wsl + WS_WMOT))
#define WpS ((bf16_t*)(wsl + WS_WPS))
#define WxqT ((bf16_t*)(wsl + WS_WXQ))
#define WxkvT ((bf16_t*)(wsl + WS_WXKV))
#define WxoT ((bf16_t*)(wsl + WS_WXO))
#define WguT ((bf16_t*)(wsl + WS_WGU))
#define WdT ((bf16_t*)(wsl + WS_WD))
#define LOGIT ((float*)(wsl + WS_LOGIT))
#define BETA ((float*)(wsl + WS_BETA))
#define GDEC ((float*)(wsl + WS_GDEC))
#define H ((bf16_t*)(wsl + WS_H))
#define AMIX ((bf16_t*)(wsl + WS_H))
#define PBUF ((bf16_t*)(wsl + WS_PBUF))
#define QKVN ((bf16_t*)(wsl + WS_QKVN))
#define ODN ((float*)(wsl + WS_ODN))
#define XQ ((bf16_t*)(wsl + WS_XQ))
#define SBUF ((float*)(wsl + WS_SBUF))
#define PATT ((bf16_t*)(wsl + WS_PATT))
#define OATT ((bf16_t*)(wsl + WS_OATT))
#define GB ((bf16_t*)(wsl + WS_G))
#define UB ((bf16_t*)(wsl + WS_U))

struct Args { const float* in[23]; float* out; unsigned char* ws; int l_lo, l_hi, ph_lo, ph_hi; int single, pad; };
constexpr int NPH = 17;

__global__ void __launch_bounds__(NTHR, 2) fwd_kernel(Args a) {
    extern __shared__ __attribute__((aligned(16))) unsigned char lds_raw[];
    LAS unsigned char* lds = (LAS unsigned char*)lds_raw;
    Ctx C0; C0.lds = lds; C0.tid = 0; C0.lane = 0; C0.wave = __builtin_amdgcn_readfirstlane(threadIdx.x >> 6);
    const int G0 = gridDim.x; const int bx0 = blockIdx.x; const int vcu = (G0 % 8 == 0) ? (bx0 % 8) * (G0 / 8) + bx0 / 8 : bx0;
    C0.gw = vcu * NWAVES + C0.wave; C0.NGW = G0 * NWAVES;
    unsigned char* ws = a.ws;
    unsigned* ctl = (unsigned*)(ws + WS_CTL);
    volatile LAS unsigned* MISC = (volatile LAS unsigned*)(lds + MISC_OFF);
    for (int u = threadIdx.x; u < (LDS_BYTES - LDSCTL_OFF) / 4; u += NTHR) ((LAS unsigned*)(lds + LDSCTL_OFF))[u] = 0u;
    __syncthreads();
    XcdBarrier bar; bar.bar = ctl + CW_BAR; bar.x = 0; bar.st = nullptr;
    if (a.single) bar = xcd_barrier_post(ctl + CW_BAR, MISC + 8);
#define SEAM() do { if (a.single) xcd_barrier(bar); } while (0)
#ifndef PH_MASK
#define PH_MASK 0x1ffff
#endif
#define IN(k) ((((PH_MASK) >> (k)) & 1) && a.ph_lo <= (k) && (k) < a.ph_hi)


    for (int l = a.l_lo; l < a.l_hi; ++l) {

        if (IN(0)) { PHASE_BEGIN();
            LAS float* scr = (LAS float*)(lds + RING_OFF + C.wave * 16384);
            const float* w_in = INP(3) + (size_t)l * DM * INW; const float* w_mo = INP(10) + (size_t)l * DM * DM;
            const float* w_xq = INP(13) + (size_t)l * DM * DM; const float* w_xkv = INP(14) + (size_t)l * DM * 2 * DM; const float* w_xo = INP(15) + (size_t)l * DM * DM;
            const float* w_g = INP(17) + (size_t)l * DM * FF; const float* w_u = INP(18) + (size_t)l * DM * FF; const float* w_d = INP(21) + (size_t)l * FF * DM;
            constexpr int I_IN = (DM / 64) * ((INW + 31) / 32), I_MO1 = (1024 / 64) * (DM / 32), I_MO2 = I_MO1, I_XQ = (DM / 64) * (DM / 32), I_XKV = (DM / 64) * (2 * DM / 32), I_XO = I_XQ,
                          I_G = (DM / 64) * (FF / 32), I_U = I_G, I_D = (FF / 64) * (DM / 32);
            constexpr int NITEMS = I_IN + I_MO1 + I_MO2 + I_XQ + I_XKV + I_XO + I_G + I_U + I_D;
            for (int it = C.gw; it < NITEMS; it += C.NGW) {
                int r = it;
                if (r < I_IN) { transpose_item(w_in, DM, INW, INW, WinT, DM, scr, r, C.lane); continue; } r -= I_IN;
                if (r < I_MO1) { transpose_item(w_mo, 1024, DM, DM, WmoT, 1024, scr, r, C.lane); continue; } r -= I_MO1;
                if (r < I_MO2) { transpose_item(w_mo + (size_t)1024 * DM, 1024, DM, DM, WfT + 1024, DM, scr, r, C.lane); continue; } r -= I_MO2;
                if (r < I_XQ) { transpose_item(w_xq, DM, DM, DM, WxqT, DM, scr, r, C.lane); continue; } r -= I_XQ;
                if (r < I_XKV) { transpose_item(w_xkv, DM, 2 * DM, 2 * DM, WxkvT, DM, scr, r, C.lane); continue; } r -= I_XKV;
                if (r < I_XO) { transpose_item(w_xo, DM, DM, DM, WxoT, DM, scr, r, C.lane); continue; } r -= I_XO;
                if (r < I_G) { transpose_item(w_g, DM, FF, FF, WguT, DM, scr, r, C.lane); continue; } r -= I_G;
                if (r < I_U) { transpose_item(w_u, DM, FF, FF, WguT + (size_t)FF * DM, DM, scr, r, C.lane); continue; } r -= I_U;
                transpose_item(w_d, FF, DM, DM, WdT, FF, scr, r, C.lane);
            }
            {
                const float* wp = INP(4) + (size_t)l * 4 * 65536; const float* ps = INP(5) + (size_t)l * 1024;
                for (int i = (C.gw * 64 + C.lane) * 4; i < 4 * 65536; i += C.NGW * 64 * 4) {
                    const f32x4 w = *(const f32x4*)(wp + i); const int g = i >> 16, j = i & 255; const f32x4 s = *(const f32x4*)(ps + g * 256 + j);
                    u32x2 o; o.x = cvt_pk_bf16(w[0] * s[0], w[1] * s[1]); o.y = cvt_pk_bf16(w[2] * s[2], w[3] * s[3]); *(u32x2*)(WpS + i) = o; }
            }
            if (l == 0) rmsnorm_rows_bf16(C, INP(1), INP(12), MEMH, MM);
            rmsnorm_rows_bf16(C, (l == 0) ? INP(0) : (const float*)Xl, INP(2) + (size_t)l * DM, H, M);
            SEAM();
        }
        if (IN(1)) { PHASE_BEGIN();
            { SchedWf S{G, bx, (const char*)WmoT, (const char*)WpS, (char*)WfT}; pg8::EpiBf16 E;
              pg8::gemm_phase<pg8::Gemm<1024, 256, 256>, pg8::EpiBf16, SchedWf, true>(lds + RING_OFF, C.tid, S, E); }
            { SchedKV S{G, bx, (const char*)MEMH, (const char*)WxkvT, (char*)KX, (char*)VT}; pg8::EpiBf16 E;
              pg8::gemm_phase<pg8::Gemm<DM, DM, DM>, pg8::EpiBf16, SchedKV, true>(lds + RING_OFF, C.tid, S, E); }
            { SchedP S{G, bx, (const char*)H, (const char*)WinT, (char*)PBUF}; pg8::EpiP E{LOGIT};
              pg8::gemm_phase<pg8::Gemm<DM, DM, DM>, pg8::EpiP, SchedP, true>(lds + RING_OFF, C.tid, S, E); }
            SEAM();
        }
        if (IN(2)) { PHASE_BEGIN();
            const float* cw = INP(6) + (size_t)l * 4 * 3072;
            const float alog = (C.lane < 8) ? INP(7)[l * 8 + C.lane] : 0.f, dtb = (C.lane < 8) ? INP(8)[l * 8 + C.lane] : 0.f;
            for (int m = C.gw; m < M; m += C.NGW) {
                const int t = m & (SEQ - 1);
                {
                    const int w = 2 << (C.lane >> 4); const int cnt = (t + 1) < w ? (t + 1) : w;
                    float s[16], u0[16];
#pragma unroll
                    for (int j = 0; j < 16; ++j) { s[j] = 0.f; u0[j] = 0.f; }
                    for (int i = 0; i < 16; ++i) {
                        if (i < cnt) { const u32x4* p = (const u32x4*)(PBUF + (size_t)(m - i) * PW + C.lane * 16); const u32x4 q0 = p[0], q1 = p[1];
                            const unsigned wds[8] = {q0.x, q0.y, q0.z, q0.w, q1.x, q1.y, q1.z, q1.w};
#pragma unroll
                            for (int j = 0; j < 8; ++j) { const float lo = bflo(wds[j]), hi = bfhi(wds[j]); s[2 * j] += lo; s[2 * j + 1] += hi; if (i == 0) { u0[2 * j] = lo; u0[2 * j + 1] = hi; } } }
                    }
                    const float inv = 1.0f / (float)cnt; unsigned o[8];
#pragma unroll
                    for (int j = 0; j < 8; ++j) o[j] = cvt_pk_bf16(s[2 * j] * inv - u0[2 * j], s[2 * j + 1] * inv - u0[2 * j + 1]);
                    u32x4* op = (u32x4*)(AMIX + (size_t)m * DM + C.lane * 16); op[0] = (u32x4){o[0], o[1], o[2], o[3]}; op[1] = (u32x4){o[4], o[5], o[6], o[7]};
                }
#pragma unroll 1
                for (int j = 0; j < 6; ++j) {
                    const int c0 = j * 512 + C.lane * 8; float y[8];
#pragma unroll
                    for (int e = 0; e < 8; ++e) y[e] = 0.f;
#pragma unroll
                    for (int k = 0; k < 4; ++k) { const int back = 3 - k;
                        if (t - back >= 0) { const u32x4 q = *(const u32x4*)(PBUF + (size_t)(m - back) * PW + 1024 + c0); const f32x4 w0 = *(const f32x4*)(cw + k * 3072 + c0), w1 = *(const f32x4*)(cw + k * 3072 + c0 + 4);
                            y[0] += w0[0] * bflo(q.x); y[1] += w0[1] * bfhi(q.x); y[2] += w0[2] * bflo(q.y); y[3] += w0[3] * bfhi(q.y);
                            y[4] += w1[0] * bflo(q.z); y[5] += w1[1] * bfhi(q.z); y[6] += w1[2] * bflo(q.w); y[7] += w1[3] * bfhi(q.w); } }
                    float ss = 0.f;
#pragma unroll
                    for (int e = 0; e < 8; ++e) { y[e] = silu_f(y[e]); ss += y[e] * y[e]; }
                    float sc = 1.0f;
                    if (j < 4) { ss += __shfl_xor(ss, 1); ss += __shfl_xor(ss, 2); ss += __shfl_xor(ss, 4); ss += __shfl_xor(ss, 8);
                        sc = rsqrtf(ss + EPS); if (j < 2) sc *= 0.08838834764831845f; }
                    u32x4 o; o.x = cvt_pk_bf16(y[0] * sc, y[1] * sc); o.y = cvt_pk_bf16(y[2] * sc, y[3] * sc); o.z = cvt_pk_bf16(y[4] * sc, y[5] * sc); o.w = cvt_pk_bf16(y[6] * sc, y[7] * sc);
                    *(u32x4*)(QKVN + (size_t)m * 3072 + c0) = o;
                }
                if (C.lane < 8) { const float bl = LOGIT[(size_t)m * 16 + C.lane], al = LOGIT[(size_t)m * 16 + 8 + C.lane] + dtb;
                    const float sp = fmaxf(al, 0.f) + log1pf(__expf(-fabsf(al)));
                    BETA[(size_t)m * 8 + C.lane] = 1.0f / (1.0f + __expf(-bl)); GDEC[(size_t)m * 8 + C.lane] = -__expf(alog) * sp; }
            }
            SEAM();
        }
        if (IN(3)) { PHASE_BEGIN();
            LAS float* Ks = (LAS float*)(lds + RING_OFF); LAS float* Qs = Ks + 64 * 128; LAS float* Vs = Qs + 64 * 128; LAS float* As = Vs + 64 * 128; LAS float* Bs = As + 64;
            for (int bh = bx; bh < BATCH * 8; bh += G) {
                const int b = bh >> 3, h = bh & 7, e = C.tid >> 2, r = C.tid & 3;
                float S[32];
#pragma unroll
                for (int d = 0; d < 32; ++d) S[d] = 0.f;
                for (int ch = 0; ch < SEQ / 64; ++ch) {
                    __syncthreads();
                    for (int i = C.tid; i < 64 * 16; i += NTHR) { const int tt = i >> 4, d8 = (i & 15) * 8; const size_t m = (size_t)b * SEQ + ch * 64 + tt;
                        const bf16_t* src = QKVN + m * 3072 + h * 128 + d8;
                        const u32x4 q = *(const u32x4*)src, k = *(const u32x4*)(src + 1024), v = *(const u32x4*)(src + 2048);
                        LAS float* qd = Qs + tt * 128 + d8; LAS float* kd = Ks + tt * 128 + d8; LAS float* vd = Vs + tt * 128 + d8;
                        *(LAS f32x4*)qd = (f32x4){bflo(q.x), bfhi(q.x), bflo(q.y), bfhi(q.y)}; *(LAS f32x4*)(qd + 4) = (f32x4){bflo(q.z), bfhi(q.z), bflo(q.w), bfhi(q.w)};
                        *(LAS f32x4*)kd = (f32x4){bflo(k.x), bfhi(k.x), bflo(k.y), bfhi(k.y)}; *(LAS f32x4*)(kd + 4) = (f32x4){bflo(k.z), bfhi(k.z), bflo(k.w), bfhi(k.w)};
                        *(LAS f32x4*)vd = (f32x4){bflo(v.x), bfhi(v.x), bflo(v.y), bfhi(v.y)}; *(LAS f32x4*)(vd + 4) = (f32x4){bflo(v.z), bfhi(v.z), bflo(v.w), bfhi(v.w)}; }
                    if (C.tid < 64) { const size_t m = (size_t)b * SEQ + ch * 64 + C.tid; As[C.tid] = __expf(GDEC[m * 8 + h]); Bs[C.tid] = BETA[m * 8 + h]; }
                    __syncthreads();
                    for (int tt = 0; tt < 64; ++tt) {
                        const float av = As[tt], beta = Bs[tt];
                        float kk[32]; float dot = 0.f;
#pragma unroll
                        for (int d4 = 0; d4 < 8; ++d4) { const f32x4 kv = *(const LAS f32x4*)(Ks + tt * 128 + r * 32 + d4 * 4); kk[4 * d4] = kv[0]; kk[4 * d4 + 1] = kv[1]; kk[4 * d4 + 2] = kv[2]; kk[4 * d4 + 3] = kv[3]; }
#pragma unroll
                        for (int d = 0; d < 32; ++d) dot += kk[d] * S[d];
                        dot += __shfl_xor(dot, 1); dot += __shfl_xor(dot, 2);
                        const float vn = beta * (Vs[tt * 128 + e] - av * dot);
#pragma unroll
                        for (int d = 0; d < 32; ++d) S[d] = av * S[d] + kk[d] * vn;
                        float od = 0.f;
#pragma unroll
                        for (int d4 = 0; d4 < 8; ++d4) { const f32x4 qv = *(const LAS f32x4*)(Qs + tt * 128 + r * 32 + d4 * 4); od += qv[0] * S[4 * d4] + qv[1] * S[4 * d4 + 1] + qv[2] * S[4 * d4 + 2] + qv[3] * S[4 * d4 + 3]; }
                        od += __shfl_xor(od, 1); od += __shfl_xor(od, 2);
                        if (r == 0) ODN[((size_t)b * SEQ + ch * 64 + tt) * 1024 + h * 128 + e] = od;
                    }
                }
            }
            __syncthreads();
            SEAM();
        }
        if (IN(4)) { PHASE_BEGIN();
            const float* ng = INP(9) + (size_t)l * 128;
            f32x4 gq[4];
#pragma unroll
            for (int j = 0; j < 4; ++j) gq[j] = *(const f32x4*)(ng + ((C.lane & 7) * 16 + 4 * j));
            for (int m = C.gw; m < M; m += C.NGW) {
                const f32x4* op = (const f32x4*)(ODN + (size_t)m * 1024 + C.lane * 16); f32x4 o[4]; float ss = 0.f;
#pragma unroll
                for (int j = 0; j < 4; ++j) { o[j] = op[j]; ss += (o[j][0] * o[j][0] + o[j][1] * o[j][1]) + (o[j][2] * o[j][2] + o[j][3] * o[j][3]); }
                ss += __shfl_xor(ss, 1); ss += __shfl_xor(ss, 2); ss += __shfl_xor(ss, 4);
                const float rstd = rsqrtf(ss * (1.f / 128.f) + EPS);
                const u32x4* zp = (const u32x4*)(PBUF + (size_t)m * PW + 4096 + C.lane * 16); const u32x4 z0 = zp[0], z1 = zp[1];
                const unsigned zw[8] = {z0.x, z0.y, z0.z, z0.w, z1.x, z1.y, z1.z, z1.w}; unsigned ow[8];
#pragma unroll
                for (int j = 0; j < 8; ++j) { const int q = j >> 1, e = (j & 1) * 2;
                    const float y0 = o[q][e] * rstd * gq[q][e] * silu_f(bflo(zw[j])), y1 = o[q][e + 1] * rstd * gq[q][e + 1] * silu_f(bfhi(zw[j])); ow[j] = cvt_pk_bf16(y0, y1); }
                u32x4* dp = (u32x4*)(AMIX + (size_t)m * DM + 1024 + C.lane * 16); dp[0] = (u32x4){ow[0], ow[1], ow[2], ow[3]}; dp[1] = (u32x4){ow[4], ow[5], ow[6], ow[7]};
            }
            SEAM();
        }
        if (IN(5)) { PHASE_BEGIN();
            SchedX S{G, bx, (const char*)AMIX, (const char*)WfT, (char*)Xl}; pg8::EpiResid E{(l == 0) ? INP(0) : (const float*)Xl, Xl};
            pg8::gemm_phase<pg8::Gemm<DM, DM, DM>, pg8::EpiResid, SchedX, true>(lds + RING_OFF, C.tid, S, E);
            SEAM();
        }
        if (IN(6)) { PHASE_BEGIN(); rmsnorm_rows_bf16(C, Xl, INP(11) + (size_t)l * DM, H, M); SEAM(); }
        if (IN(7)) { PHASE_BEGIN();
            SchedQ S{G, bx, (const char*)H, (const char*)WxqT, (char*)XQ}; pg8::EpiBf16 E;
            pg8::gemm_phase<pg8::Gemm<DM, DM, DM>, pg8::EpiBf16, SchedQ, true>(lds + RING_OFF, C.tid, S, E);
            SEAM();
        }
        if (IN(8)) { PHASE_BEGIN();
            SchedS S{G, bx, (const char*)XQ, (const char*)KX, (char*)SBUF}; pg8::EpiF32Scale E{0.04419417382415922f};
            pg8::gemm_phase<pg8::Gemm<DM, DM, 512>, pg8::EpiF32Scale, SchedS, true>(lds + RING_OFF, C.tid, S, E);
            SEAM();
        }
        if (IN(9)) { PHASE_BEGIN();
            for (int m = C.gw; m < M; m += C.NGW) {
                const f32x4* sp = (const f32x4*)(SBUF + (size_t)m * 1024 + C.lane * 16); f32x4 s[4]; float mx = -3.0e38f;
#pragma unroll
                for (int j = 0; j < 4; ++j) { s[j] = sp[j]; mx = fmaxf(mx, fmaxf(fmaxf(s[j][0], s[j][1]), fmaxf(s[j][2], s[j][3]))); }
                mx = fmaxf(mx, __shfl_xor(mx, 1)); mx = fmaxf(mx, __shfl_xor(mx, 2)); mx = fmaxf(mx, __shfl_xor(mx, 4)); mx = fmaxf(mx, __shfl_xor(mx, 8));
                float sum = 0.f;
#pragma unroll
                for (int j = 0; j < 4; ++j) {
#pragma unroll
                    for (int e = 0; e < 4; ++e) { s[j][e] = __expf(s[j][e] - mx); sum += s[j][e]; } }
                sum += __shfl_xor(sum, 1); sum += __shfl_xor(sum, 2); sum += __shfl_xor(sum, 4); sum += __shfl_xor(sum, 8);
                const float inv = 1.0f / sum; unsigned ow[8];
#pragma unroll
                for (int j = 0; j < 4; ++j) { ow[2 * j] = cvt_pk_bf16(s[j][0] * inv, s[j][1] * inv); ow[2 * j + 1] = cvt_pk_bf16(s[j][2] * inv, s[j][3] * inv); }
                u32x4* dp = (u32x4*)(PATT + (size_t)m * 1024 + C.lane * 16); dp[0] = (u32x4){ow[0], ow[1], ow[2], ow[3]}; dp[1] = (u32x4){ow[4], ow[5], ow[6], ow[7]};
            }
            SEAM();
        }
        if (IN(10)) { PHASE_BEGIN();
            SchedPV S{G, bx, (const char*)PATT, (const char*)VT, (char*)OATT}; pg8::EpiBf16 E;
            pg8::gemm_phase<pg8::Gemm<1024, 256, 256>, pg8::EpiBf16, SchedPV, true>(lds + RING_OFF, C.tid, S, E);
            SEAM();
        }
        if (IN(11)) { PHASE_BEGIN();
            SchedX S{G, bx, (const char*)OATT, (const char*)WxoT, (char*)Xl}; pg8::EpiResid E{Xl, Xl};
            pg8::gemm_phase<pg8::Gemm<DM, DM, DM>, pg8::EpiResid, SchedX, true>(lds + RING_OFF, C.tid, S, E);
            SEAM();
        }
        if (IN(12)) { PHASE_BEGIN(); rmsnorm_rows_bf16(C, Xl, INP(16) + (size_t)l * DM, H, M); SEAM(); }
        if (IN(13)) { PHASE_BEGIN();
            SchedGU S{G, bx, (const char*)H, (const char*)WguT, (char*)GB, (char*)UB}; pg8::EpiBf16 E;
            pg8::gemm_phase<pg8::Gemm<DM, DM, DM>, pg8::EpiBf16, SchedGU, true>(lds + RING_OFF, C.tid, S, E);
            SEAM();
        }
        if (IN(14)) { PHASE_BEGIN();
            const float* cw = INP(19) + (size_t)l * 3 * FF; const float* cb = INP(20) + (size_t)l * FF;
            for (int m = C.gw; m < M; m += C.NGW) {
                const int t = m & (SEQ - 1);
#pragma unroll 1
                for (int j = 0; j < 11; ++j) {
                    const int c0 = j * 512 + C.lane * 8; float y[8];
                    { const f32x4 b0 = *(const f32x4*)(cb + c0), b1 = *(const f32x4*)(cb + c0 + 4); y[0] = b0[0]; y[1] = b0[1]; y[2] = b0[2]; y[3] = b0[3]; y[4] = b1[0]; y[5] = b1[1]; y[6] = b1[2]; y[7] = b1[3]; }
#pragma unroll
                    for (int k = 0; k < 3; ++k) { const int back = 2 - k;
                        if (t - back >= 0) { const u32x4 q = *(const u32x4*)(GB + (size_t)(m - back) * FF + c0); const f32x4 w0 = *(const f32x4*)(cw + k * FF + c0), w1 = *(const f32x4*)(cw + k * FF + c0 + 4);
                            y[0] += w0[0] * bflo(q.x); y[1] += w0[1] * bfhi(q.x); y[2] += w0[2] * bflo(q.y); y[3] += w0[3] * bfhi(q.y);
                            y[4] += w1[0] * bflo(q.z); y[5] += w1[1] * bfhi(q.z); y[6] += w1[2] * bflo(q.w); y[7] += w1[3] * bfhi(q.w); } }
                    u32x4* up = (u32x4*)(UB + (size_t)m * FF + c0); const u32x4 uv = *up;
                    u32x4 o; o.x = cvt_pk_bf16(silu_f(y[0]) * bflo(uv.x), silu_f(y[1]) * bfhi(uv.x)); o.y = cvt_pk_bf16(silu_f(y[2]) * bflo(uv.y), silu_f(y[3]) * bfhi(uv.y));
                    o.z = cvt_pk_bf16(silu_f(y[4]) * bflo(uv.z), silu_f(y[5]) * bfhi(uv.z)); o.w = cvt_pk_bf16(silu_f(y[6]) * bflo(uv.w), silu_f(y[7]) * bfhi(uv.w));
                    *up = o;
                }
            }
            SEAM();
        }
        if (IN(15)) { PHASE_BEGIN();
            SchedD S{G, bx, (const char*)UB, (const char*)WdT, (char*)Xl}; pg8::EpiResid E{Xl, Xl};
            pg8::gemm_phase<pg8::Gemm<FF, FF, FF>, pg8::EpiResid, SchedD, true>(lds + RING_OFF, C.tid, S, E);
            if (l != DEPTH - 1 || IN(16)) SEAM();
        }
        if (IN(16) && l == DEPTH - 1) { PHASE_BEGIN(); (void)wsl; (void)bx; (void)G; rmsnorm_rows_f32(C, Xl, INP(22), M); }
    }
#undef SEAM
#undef IN
}

extern "C" void kernel_launch(void* const* d_in, const int* in_sizes, int n_in, void* d_out, int out_size, void* d_ws, size_t ws_size, hipStream_t stream) {
    static int grid = 0;
    if (grid == 0) {
        if (n_in != 23 || in_sizes[0] != M * DM || out_size != M * DM || ws_size < WS_END) { fprintf(stderr, "kernel_launch: unexpected shapes (n_in %d, in0 %d, out %d, ws %zu)\n", n_in, n_in > 0 ? in_sizes[0] : -1, out_size, ws_size); grid = -1; return; }
        int dev = 0, cus = 0, per_cu = 0;
        if (hipGetDevice(&dev) != hipSuccess || hipDeviceGetAttribute(&cus, hipDeviceAttributeMultiprocessorCount, dev) != hipSuccess) { grid = -1; return; }
        if (hipFuncSetAttribute((const void*)fwd_kernel, hipFuncAttributeMaxDynamicSharedMemorySize, LDS_BYTES) != hipSuccess) { fprintf(stderr, "kernel_launch: hipFuncSetAttribute failed\n"); grid = -1; return; }
        if (hipOccupancyMaxActiveBlocksPerMultiprocessor(&per_cu, (const void*)fwd_kernel, NTHR, LDS_BYTES) != hipSuccess || per_cu < 1) fprintf(stderr, "kernel_launch: occupancy query says %d\n", per_cu);
        (void)hipGetLastError();
        grid = cus;
    }
    if (grid < 0) return;
    if (hipMemsetAsync((char*)d_ws + WS_CTL, 0, CTL_ZERO_BYTES, stream) != hipSuccess) return;
    Args a{};
    for (int i = 0; i < 23; ++i) a.in[i] = (const float*)d_in[i];
    a.out = (float*)d_out; a.ws = (unsigned char*)d_ws; a.pad = 0;
#if ONE_LAUNCH
    a.l_lo = 0; a.l_hi = DEPTH; a.ph_lo = 0; a.ph_hi = NPH; a.single = 1;
    hipLaunchKernelGGL(fwd_kernel, dim3(grid), dim3(NTHR), LDS_BYTES, stream, a);
#else
    a.single = 0;
    for (int l = 0; l < DEPTH; ++l)
        for (int p = 0; p < NPH; ++p) {
            if (p == NPH - 1 && l != DEPTH - 1) continue;
            a.l_lo = l; a.l_hi = l + 1; a.ph_lo = p; a.ph_hi = p + 1;
            hipLaunchKernelGGL(fwd_kernel, dim3(grid), dim3(NTHR), LDS_BYTES, stream, a);
        }
#endif
}
```

```cpp
#include <hip/hip_runtime.h>
#include <cstdio>
#include <cstdint>

#ifndef ONE_LAUNCH
#define ONE_LAUNCH 1
#endif

#define LAS __attribute__((address_space(3)))
#define GAS __attribute__((address_space(1)))
typedef unsigned short bf16_t;
typedef short bf16x8 __attribute__((ext_vector_type(8)));
typedef float f32x4 __attribute__((ext_vector_type(4)));
typedef float f32x2 __attribute__((ext_vector_type(2)));
typedef unsigned u32x4 __attribute__((ext_vector_type(4)));
typedef unsigned u32x2 __attribute__((ext_vector_type(2)));

constexpr int DM = 2048, BATCH = 16, SEQ = 2048, DEPTH = 4, MEM_LEN = 256;
constexpr int M = BATCH * SEQ;
constexpr int MM = BATCH * MEM_LEN;
constexpr int INW = 5136, INW_PAD = 5376, PW = 5120;
constexpr int FF = 5632;
constexpr int NWAVES = 8, NTHR = 512;
constexpr float EPS = 1e-6f;

constexpr size_t MiB = 1u << 20;
constexpr size_t WS_CTL = 0, CTL_ZERO_BYTES = 1 * MiB;
constexpr size_t WS_MEMH = 2 * MiB, WS_KX = 18 * MiB, WS_VT = 34 * MiB;
constexpr size_t WS_WIN = 50 * MiB, WS_WF = 71 * MiB, WS_WMOT = 79 * MiB, WS_WPS = 83 * MiB, WS_WXQ = 84 * MiB, WS_WXKV = 92 * MiB, WS_WXO = 108 * MiB, WS_WGU = 116 * MiB, WS_WD = 160 * MiB;
constexpr size_t WS_LOGIT = 182 * MiB, WS_BETA = 184 * MiB, WS_GDEC = 185 * MiB;
constexpr size_t WS_H = 192 * MiB;
constexpr size_t WS_PBUF = 320 * MiB, WS_QKVN = 640 * MiB, WS_ODN = 832 * MiB;
constexpr size_t WS_WQK = 1188 * MiB, WS_WOV = 512 * MiB, WS_PATT = 576 * MiB;
constexpr size_t WS_G = 320 * MiB, WS_U = 672 * MiB;
constexpr size_t WS_HALO = 680 * MiB, WS_FIXG = 688 * MiB, WS_FIXU = 696 * MiB;
constexpr size_t WS_SSQ = 960 * MiB, WS_RSTD = 964 * MiB;
constexpr size_t WS_REC = 1024 * MiB;
constexpr size_t REC_BYTES = 41984, REC_NW = 0, REC_U = 16384, REC_AT = 32768, REC_MISC = 40960;
constexpr size_t WS_END = 1252 * MiB;
constexpr int CW_BAR = 4096;

typedef __bf16 bf16x2_t __attribute__((ext_vector_type(2)));
__device__ __forceinline__ unsigned cvt_pk_bf16_c(float lo, float hi) { const f32x2 v = {lo, hi}; return __builtin_bit_cast(unsigned, __builtin_convertvector(v, bf16x2_t)); }
__device__ __forceinline__ unsigned cvt_pk_bf16(float lo, float hi) { unsigned r; asm("v_cvt_pk_bf16_f32 %0, %1, %2" : "=v"(r) : "v"(lo), "v"(hi)); return r; }
__device__ __forceinline__ float bflo(unsigned u) { return __uint_as_float(u << 16); }
__device__ __forceinline__ float bfhi(unsigned u) { return __uint_as_float(u & 0xffff0000u); }
template <int X> __device__ __forceinline__ float sx(float v) { return __builtin_bit_cast(float, __builtin_amdgcn_ds_swizzle(__builtin_bit_cast(int, v), (X << 10) | 0x1f)); }
__device__ __forceinline__ float wave_sum(float v) {
    v += sx<1>(v); v += sx<2>(v); v += sx<4>(v); v += sx<8>(v); v += sx<16>(v);
    return __builtin_bit_cast(float, __builtin_amdgcn_readlane(__builtin_bit_cast(int, v), 0)) + __builtin_bit_cast(float, __builtin_amdgcn_readlane(__builtin_bit_cast(int, v), 32));
}
__device__ __forceinline__ float silu_f(float y) { return y * __builtin_amdgcn_rcpf(1.0f + __expf(-y)); }
#define LDS_WAIT() asm volatile("s_waitcnt lgkmcnt(0)" ::: "memory")

namespace pg8 {
constexpr int BM = 256, BK = 64, HALF = 128, HTB = HALF * BK * 2, STAGE_BYTES = 8 * HTB, NXCD = 8, WGM = 4;
__host__ __device__ __forceinline__ int lds_byte(int r, int c) { const int st = (r >> 4) * 2 + (c >> 5), rr = r & 15, cc = c & 31, ob = rr * 64 + cc * 2; return st * 1024 + (ob ^ (((ob >> 9) & 1) << 5)); }
__host__ __device__ __forceinline__ void stage_rc(int b, int& R, int& C) { const int st = b / 1024, sb = b % 1024, swz = sb ^ (((sb >> 9) & 1) << 5); R = (st >> 1) * 16 + swz / 64; C = (st & 1) * 32 + (swz % 64) / 2; }
__host__ __device__ __forceinline__ int perm32(int rho) { const int n = rho >> 4, i = rho & 15; return 8 * (i >> 2) + 4 * n + (i & 3); }

struct Unit { int pm, pn; };
template <int LDA, int LDB, int KK> struct Gemm { static constexpr int lda = LDA, ldb = LDB, K = KK; };

__device__ __forceinline__ bool tile_of(int i, int G, int c, int nM, int nN, int& pm, int& pn) {
    const int nwg = nM * nN; const long L = (long)i * G + c; if (L >= nwg) return false;
    int wgid = (int)L; { const int q = nwg / NXCD, r = nwg % NXCD, xcd = wgid % NXCD, off = wgid / NXCD; wgid = (xcd < r ? xcd * (q + 1) : r * (q + 1) + (xcd - r) * q) + off; }
    const int nig = WGM * nN, gid = wgid / nig, fm = gid * WGM, gsz = (nM - fm) < WGM ? (nM - fm) : WGM;
    pm = fm + ((wgid % nig) % gsz); pn = (wgid % nig) / gsz; return true;
}

struct NoPre {};
struct RsPre { float r[2][4]; };
__device__ __forceinline__ RsPre load_rstd(const float* rstd, const Unit& u, int wr, int fr) { RsPre p;
#pragma unroll
    for (int ai = 0; ai < 2; ++ai)
#pragma unroll
        for (int m = 0; m < 4; ++m) p.r[ai][m] = ((const GAS float*)rstd)[u.pm * BM + wr * 64 + fr + ai * HALF + m * 16];
    return p; }
struct EpiBf16 {
    static constexpr bool PERM = true;
    __device__ __forceinline__ NoPre pre(const Unit& u, int wr, int fr) const { (void)u; (void)wr; (void)fr; return NoPre{}; }
    __device__ __forceinline__ int tail(const Unit&) const { return 16; }
    template <class Sched> __device__ __forceinline__ void operator()(const f32x4 (&acc)[2][2][4][2], const Unit& u, const Sched& S, int wr, int wc, int fr, int fq, const NoPre& pre) const {
        const int ldc = S.ldc(u);
        GAS bf16_t* base = (GAS bf16_t*)S.optr(u) + (size_t)(wr * 64 + fr) * ldc + wc * 32 + 8 * fq;
#pragma unroll
        for (int ai = 0; ai < 2; ++ai)
#pragma unroll
            for (int m = 0; m < 4; ++m) { GAS bf16_t* rowp = base + (size_t)(ai * HALF + m * 16) * ldc;
#pragma unroll
                for (int bj = 0; bj < 2; ++bj) { const f32x4 v0 = acc[ai][bj][m][0], v1 = acc[ai][bj][m][1];
                    u32x4 w; w.x = cvt_pk_bf16(v0[0], v0[1]); w.y = cvt_pk_bf16(v0[2], v0[3]); w.z = cvt_pk_bf16(v1[0], v1[1]); w.w = cvt_pk_bf16(v1[2], v1[3]);
                    *(GAS u32x4*)(rowp + bj * HALF) = w; } }
    }
};
struct EpiP {
    static constexpr bool PERM = true;
    float* logit; const float* rstd;
    __device__ __forceinline__ RsPre pre(const Unit& u, int wr, int fr) const { return load_rstd(rstd, u, wr, fr); }
    __device__ __forceinline__ int tail(const Unit& u) const { (void)u; return 16; }
    template <class Sched> __device__ __forceinline__ void operator()(const f32x4 (&acc)[2][2][4][2], const Unit& u, const Sched& S, int wr, int wc, int fr, int fq, const RsPre& pre) const {
        const float (&rs)[2][4] = pre.r;
        {
            const int ldc = S.ldc(u);
            GAS bf16_t* base = (GAS bf16_t*)S.optr(u) + (size_t)(wr * 64 + fr) * ldc + wc * 32 + 8 * fq;
#pragma unroll
            for (int ai = 0; ai < 2; ++ai)
#pragma unroll
                for (int m = 0; m < 4; ++m) { GAS bf16_t* rowp = base + (size_t)(ai * HALF + m * 16) * ldc; const float r = rs[ai][m];
#pragma unroll
                    for (int bj = 0; bj < 2; ++bj) { const f32x4 v0 = acc[ai][bj][m][0] * r, v1 = acc[ai][bj][m][1] * r;
                        u32x4 w; w.x = cvt_pk_bf16(v0[0], v0[1]); w.y = cvt_pk_bf16(v0[2], v0[3]); w.z = cvt_pk_bf16(v1[0], v1[1]); w.w = cvt_pk_bf16(v1[2], v1[3]);
                        *(GAS u32x4*)(rowp + bj * HALF) = w; } }
        }
    }
};
struct EpiResid {
    static constexpr bool PERM = true;
    const bf16_t* base; bf16_t* out; float* ssq;
    __device__ __forceinline__ NoPre pre(const Unit& u, int wr, int fr) const { (void)u; (void)wr; (void)fr; return NoPre{}; }
    __device__ __forceinline__ int tail(const Unit&) const { return 16; }
    template <class Sched> __device__ __forceinline__ void operator()(const f32x4 (&acc)[2][2][4][2], const Unit& u, const Sched&, int wr, int wc, int fr, int fq, const NoPre& pre) const {
        const size_t off0 = (size_t)(u.pm * BM + wr * 64 + fr) * DM + u.pn * BM + wc * 32 + 8 * fq;
        const int lane = fq * 16 + fr;
        u32x4 bs[2][4][2];
#pragma unroll
        for (int ai = 0; ai < 2; ++ai)
#pragma unroll
            for (int m = 0; m < 4; ++m)
#pragma unroll
                for (int bj = 0; bj < 2; ++bj) bs[ai][m][bj] = *(const GAS u32x4*)((const GAS bf16_t*)base + off0 + (size_t)(ai * HALF + m * 16) * DM + bj * HALF);
        GAS float* sp = (GAS float*)ssq + (size_t)(u.pm * BM + wr * 64 + fr) * 32 + u.pn * 4 + wc;
#pragma unroll
        for (int ai = 0; ai < 2; ++ai)
#pragma unroll
            for (int m = 0; m < 4; ++m) { float sq = 0.f;
#pragma unroll
                for (int bj = 0; bj < 2; ++bj) { const u32x4 b = bs[ai][m][bj]; const f32x4 v0 = acc[ai][bj][m][0], v1 = acc[ai][bj][m][1];
                    const float x0 = bflo(b.x) + v0[0], x1 = bfhi(b.x) + v0[1], x2 = bflo(b.y) + v0[2], x3 = bfhi(b.y) + v0[3], x4 = bflo(b.z) + v1[0], x5 = bfhi(b.z) + v1[1], x6 = bflo(b.w) + v1[2], x7 = bfhi(b.w) + v1[3];
                    sq += ((x0 * x0 + x1 * x1) + (x2 * x2 + x3 * x3)) + ((x4 * x4 + x5 * x5) + (x6 * x6 + x7 * x7));
                    u32x4 w; w.x = cvt_pk_bf16(x0, x1); w.y = cvt_pk_bf16(x2, x3); w.z = cvt_pk_bf16(x4, x5); w.w = cvt_pk_bf16(x6, x7);
                    *(GAS u32x4*)((GAS bf16_t*)out + off0 + (size_t)(ai * HALF + m * 16) * DM + bj * HALF) = w; }
                sq += sx<16>(sq); sq += __builtin_bit_cast(float, __builtin_amdgcn_ds_bpermute((lane ^ 32) << 2, __builtin_bit_cast(int, sq)));
                if (fq == 0) sp[(size_t)(ai * HALF + m * 16) * 32] = sq; }
    }
};
template <int N> __device__ __forceinline__ float dpp_shr(float old, float x) { return __builtin_bit_cast(float, __builtin_amdgcn_update_dpp(__builtin_bit_cast(int, old), __builtin_bit_cast(int, x), 0x110 + N, 0xf, 0xf, false)); }
template <int N> __device__ __forceinline__ float dpp_ror(float x) { return __builtin_bit_cast(float, __builtin_amdgcn_update_dpp(0, __builtin_bit_cast(int, x), 0x120 + N, 0xf, 0xf, false)); }
struct EpiGLU {
    static constexpr bool PERM = true;
    const float* cw; const float* cb; bf16_t* hf; float* halo_g; float* fix_g; float* fix_u; LAS float* ex; const float* rstd;
    __device__ __forceinline__ RsPre pre(const Unit& u, int wr, int fr) const { return load_rstd(rstd, u, wr, fr); }
    __device__ __forceinline__ int tail(const Unit&) const { return 8; }
    template <class Sched> __device__ __forceinline__ void operator()(const f32x4 (&acc_)[2][2][4][2], const Unit& u, const Sched&, int wr, int wc, int fr, int fq, const RsPre& pre) const {
        f32x4 (&acc)[2][2][4][2] = const_cast<f32x4 (&)[2][2][4][2]>(acc_);
#pragma unroll
        for (int ai = 0; ai < 2; ++ai)
#pragma unroll
            for (int m = 0; m < 4; ++m) { const float r = pre.r[ai][m], ru = r * -0.6931471805599453f;
#pragma unroll
                for (int n = 0; n < 2; ++n) { acc[ai][0][m][n] = acc[ai][0][m][n] * r; acc[ai][1][m][n] = acc[ai][1][m][n] * ru; } }
        const int col0 = wc * 32 + 8 * fq, gcol = u.pn * 128 + col0;
        if (fr >= 14) {
#pragma unroll
            for (int ai = 0; ai < 2; ++ai)
#pragma unroll
                for (int n = 0; n < 2; ++n) *(LAS f32x4*)(ex + ((ai * 2 + wr) * 2 + (fr - 14)) * 128 + col0 + 4 * n) = acc[ai][0][3][n];
            if (wr == 1) {
#pragma unroll
                for (int n = 0; n < 2; ++n) *(GAS f32x4*)((GAS float*)halo_g + (size_t)(u.pm * 2 + (fr - 14)) * FF + gcol + 4 * n) = acc[1][0][3][n]; }
        }
        if (wr == 0 && fr < 2) {
#pragma unroll
            for (int n = 0; n < 2; ++n) { *(GAS f32x4*)((GAS float*)fix_g + (size_t)(u.pm * 2 + fr) * FF + gcol + 4 * n) = acc[0][0][0][n]; *(GAS f32x4*)((GAS float*)fix_u + (size_t)(u.pm * 2 + fr) * FF + gcol + 4 * n) = acc[0][1][0][n]; } }
        f32x4 w0[2], w1[2], w2[2], bb[2];
#pragma unroll
        for (int n = 0; n < 2; ++n) { const GAS float* cwg = (const GAS float*)cw; w0[n] = *(const GAS f32x4*)(cwg + gcol + 4 * n); w1[n] = *(const GAS f32x4*)(cwg + FF + gcol + 4 * n); w2[n] = *(const GAS f32x4*)(cwg + 2 * FF + gcol + 4 * n); bb[n] = *(const GAS f32x4*)((const GAS float*)cb + gcol + 4 * n);
            w0[n] = w0[n] * -1.4426950408889634f; w1[n] = w1[n] * -1.4426950408889634f; w2[n] = w2[n] * -1.4426950408889634f; bb[n] = bb[n] * -1.4426950408889634f; }
        asm volatile("s_waitcnt lgkmcnt(0)" ::: "memory"); __builtin_amdgcn_s_barrier(); asm volatile("" ::: "memory");
        GAS bf16_t* hb = (GAS bf16_t*)hf + (size_t)(u.pm * BM + wr * 64 + fr) * FF + gcol;
#pragma unroll
        for (int ai = 0; ai < 2; ++ai) {
            f32x4 yp[2];
            if (ai == 0 && wr == 0) { yp[0] = (f32x4){0.f, 0.f, 0.f, 0.f}; yp[1] = yp[0]; }
            else { const int pb = wr == 1 ? ai * 2 : (ai - 1) * 2 + 1; const LAS float* e = ex + (pb * 2 + (fr >= 14 ? fr - 14 : 0)) * 128 + col0;
                yp[0] = *(const LAS f32x4*)e; yp[1] = *(const LAS f32x4*)(e + 4); }
#pragma unroll
            for (int m = 0; m < 4; ++m) {
                u32x4 ow;
#pragma unroll
                for (int n = 0; n < 2; ++n) { const f32x4 g0 = acc[ai][0][m][n], up = acc[ai][1][m][n]; float hv[4];
#pragma unroll
                    for (int j = 0; j < 4; ++j) { const float g1 = dpp_shr<1>(dpp_ror<1>(yp[n][j]), g0[j]), g2 = dpp_shr<2>(dpp_ror<2>(yp[n][j]), g0[j]);
                        const float y = bb[n][j] + w2[n][j] * g0[j] + w1[n][j] * g1 + w0[n][j] * g2; hv[j] = (y * __builtin_amdgcn_rcpf(1.0f + __builtin_amdgcn_exp2f(y))) * up[j]; }
                    if (n == 0) { ow.x = cvt_pk_bf16(hv[0], hv[1]); ow.y = cvt_pk_bf16(hv[2], hv[3]); } else { ow.z = cvt_pk_bf16(hv[0], hv[1]); ow.w = cvt_pk_bf16(hv[2], hv[3]); }
                    yp[n] = g0; }
                *(GAS u32x4*)(hb + (size_t)(ai * HALF + m * 16) * FF) = ow;
            }
        }
    }
};

struct EpiSoftmax {
    static constexpr bool PERM = true;
    float scale; LAS float* red; const float* rstd;
    __device__ __forceinline__ RsPre pre(const Unit& u, int wr, int fr) const { return load_rstd(rstd, u, wr, fr); }
    __device__ __forceinline__ int tail(const Unit&) const { return 16; }
    template <class Sched> __device__ __forceinline__ void operator()(const f32x4 (&acc_)[2][2][4][2], const Unit& u, const Sched& S, int wr, int wc, int fr, int fq, const RsPre& pre) const {
        f32x4 (&acc)[2][2][4][2] = const_cast<f32x4 (&)[2][2][4][2]>(acc_);
        const int lane = fq * 16 + fr; float mw[2][4];
#pragma unroll
        for (int ai = 0; ai < 2; ++ai)
#pragma unroll
            for (int m = 0; m < 4; ++m) {
                float mx = -3.0e38f; const float rsc = scale * pre.r[ai][m];
#pragma unroll
                for (int bj = 0; bj < 2; ++bj)
#pragma unroll
                    for (int n = 0; n < 2; ++n) { const f32x4 v = acc[ai][bj][m][n] * rsc; acc[ai][bj][m][n] = v; mx = fmaxf(mx, fmaxf(fmaxf(v[0], v[1]), fmaxf(v[2], v[3]))); }
                mx = fmaxf(mx, sx<16>(mx)); mx = fmaxf(mx, __builtin_bit_cast(float, __builtin_amdgcn_ds_bpermute((lane ^ 32) << 2, __builtin_bit_cast(int, mx))));
                float sm = 0.f;
#pragma unroll
                for (int bj = 0; bj < 2; ++bj)
#pragma unroll
                    for (int n = 0; n < 2; ++n) { f32x4 v = acc[ai][bj][m][n]; v[0] = __expf(v[0] - mx); v[1] = __expf(v[1] - mx); v[2] = __expf(v[2] - mx); v[3] = __expf(v[3] - mx); acc[ai][bj][m][n] = v; sm += (v[0] + v[1]) + (v[2] + v[3]); }
                sm += sx<16>(sm); sm += __builtin_bit_cast(float, __builtin_amdgcn_ds_bpermute((lane ^ 32) << 2, __builtin_bit_cast(int, sm)));
                mw[ai][m] = mx;
                if (fq == 0) *(LAS f32x2*)(red + ((ai * HALF + wr * 64 + m * 16 + fr) * 4 + wc) * 2) = (f32x2){mx, sm};
            }
        asm volatile("s_waitcnt lgkmcnt(0)" ::: "memory"); __builtin_amdgcn_s_barrier(); asm volatile("" ::: "memory");
        const int ldc = S.ldc(u);
        GAS bf16_t* base = (GAS bf16_t*)S.optr(u) + (size_t)(wr * 64 + fr) * ldc + wc * 32 + 8 * fq;
#pragma unroll
        for (int ai = 0; ai < 2; ++ai)
#pragma unroll
            for (int m = 0; m < 4; ++m) {
                const LAS f32x4* rp = (const LAS f32x4*)(red + (ai * HALF + wr * 64 + m * 16 + fr) * 8); const f32x4 p0 = rp[0], p1 = rp[1];
                const float M4 = fmaxf(fmaxf(p0[0], p0[2]), fmaxf(p1[0], p1[2]));
                const float tot = (p0[1] * __expf(p0[0] - M4) + p0[3] * __expf(p0[2] - M4)) + (p1[1] * __expf(p1[0] - M4) + p1[3] * __expf(p1[2] - M4));
                const float f = __expf(mw[ai][m] - M4) * __builtin_amdgcn_rcpf(tot);
                GAS bf16_t* rowp = base + (size_t)(ai * HALF + m * 16) * ldc;
#pragma unroll
                for (int bj = 0; bj < 2; ++bj) { const f32x4 v0 = acc[ai][bj][m][0] * f, v1 = acc[ai][bj][m][1] * f;
                    u32x4 w; w.x = cvt_pk_bf16(v0[0], v0[1]); w.y = cvt_pk_bf16(v0[2], v0[3]); w.z = cvt_pk_bf16(v1[0], v1[1]); w.w = cvt_pk_bf16(v1[2], v1[3]);
                    *(GAS u32x4*)(rowp + bj * HALF) = w; }
            }
    }
};

struct EpiF32Scale {
    static constexpr bool PERM = false;
    float scale;
    __device__ __forceinline__ int tail(const Unit&) const { return 0; }
    template <class Sched> __device__ __forceinline__ void operator()(const f32x4 (&acc)[2][2][4][2], const Unit& u, const Sched& S, int wr, int wc, int fr, int fq) const {
        const int ldc = S.ldc(u);
        float* base = (float*)S.optr(u) + (size_t)(wr * 64 + fr) * ldc + wc * 32 + 4 * fq;
#pragma unroll
        for (int ai = 0; ai < 2; ++ai)
#pragma unroll
            for (int m = 0; m < 4; ++m) { float* rowp = base + (size_t)(ai * HALF + m * 16) * ldc;
#pragma unroll
                for (int bj = 0; bj < 2; ++bj)
#pragma unroll
                    for (int n = 0; n < 2; ++n) *(f32x4*)(rowp + bj * HALF + n * 16) = acc[ai][bj][m][n] * scale; }
    }
};

template <class G_, class Epi, class Sched, bool ALIGN_EPI>
__device__ __forceinline__ void gemm_phase(LAS unsigned char* lds, const int tid, const Sched& S, const Epi& E) {
    constexpr G_ g{};
    const int wid = __builtin_amdgcn_readfirstlane(tid >> 6), lane = tid & 63, wr = wid >> 2, wc = wid & 3, fr = lane & 15, fq = lane >> 4;
    constexpr int K = g.K, nt = K / BK;
    unsigned voffA[2], voffB[2];
#pragma unroll
    for (int i = 0; i < 2; ++i) { int R, C; stage_rc(tid * 16 + i * 8192, R, C); const int Rb = Epi::PERM ? ((R & ~31) + perm32(R & 31)) : R;
        voffA[i] = (unsigned)(R * g.lda + C) * 2u; voffB[i] = (unsigned)(Rb * g.ldb + C) * 2u; }
    const size_t kstep = (size_t)(BK * 2);
    const size_t hstepA = (size_t)HALF * g.lda * 2, hstepB = (size_t)HALF * g.ldb * 2;
    const unsigned ldsw = (unsigned)wid * 1024u;
    const int aoff = lds_byte(wr * 64 + fr, fq * 8), boff = lds_byte(wc * 32 + fr, fq * 8);
#define PG8_SA(b, h) (((b) * 2 + (h)) * HTB)
#define PG8_SB(b, h) ((4 + (b) * 2 + (h)) * HTB)
#define PG8_STAGE(bufoff, gbase, voff) do { _Pragma("unroll") for (int _i = 0; _i < 2; ++_i) \
        __builtin_amdgcn_global_load_lds((const unsigned*)((const char*)(gbase) + (voff)[_i]), (LAS unsigned*)(lds + (bufoff) + ldsw + _i * 8192), 16, 0, 0); } while (0)
#define PG8_LDA(dst, b, h) do { _Pragma("unroll") for (int m = 0; m < 4; ++m) _Pragma("unroll") for (int k = 0; k < 2; ++k) dst[m][k] = *(const LAS bf16x8*)(lds + PG8_SA(b, h) + aoff + m * 2048 + k * 1024); } while (0)
#define PG8_LDB(dst, b, h) do { _Pragma("unroll") for (int n = 0; n < 2; ++n) _Pragma("unroll") for (int k = 0; k < 2; ++k) dst[n][k] = *(const LAS bf16x8*)(lds + PG8_SB(b, h) + boff + n * 2048 + k * 1024); } while (0)
#define PG8_MMA(ai, bj, At, Bt) do { __builtin_amdgcn_s_setprio(1); _Pragma("unroll") for (int m = 0; m < 4; ++m) _Pragma("unroll") for (int n = 0; n < 2; ++n) _Pragma("unroll") for (int k = 0; k < 2; ++k) \
        acc[ai][bj][m][n] = __builtin_amdgcn_mfma_f32_16x16x32_bf16(Bt[n][k], At[m][k], acc[ai][bj][m][n], 0, 0, 0); __builtin_amdgcn_s_setprio(0); } while (0)
#define PG8_WAIT_V(n) asm volatile("s_waitcnt vmcnt(" #n ")" ::: "memory")
#define PG8_WAIT_L(n) asm volatile("s_waitcnt lgkmcnt(" #n ")" ::: "memory")
#define PG8_WAIT_VR(tl) do { if ((tl) == 0) PG8_WAIT_V(8); else if ((tl) == 16) PG8_WAIT_V(24); else if ((tl) == 8) PG8_WAIT_V(16); else PG8_WAIT_V(12); } while (0)
#define PG8_BAR __builtin_amdgcn_s_barrier()
#define PG8_SCHED __builtin_amdgcn_sched_barrier(0)
    Unit cur, nxt; int ui = 0, ptail = 0;
    if (!S.next(0, cur)) return;
    f32x4 acc[2][2][4][2];
#pragma unroll
    for (int a = 0; a < 2; ++a)
#pragma unroll
        for (int b = 0; b < 2; ++b)
#pragma unroll
            for (int m = 0; m < 4; ++m)
#pragma unroll
                for (int n = 0; n < 2; ++n) acc[a][b][m][n] = (f32x4){0.f, 0.f, 0.f, 0.f};
    bf16x8 At[4][2], B0[2][2], B1[2][2];
    const char* cA = S.aptr(cur); const char* cB = S.bptr(cur);
    PG8_STAGE(PG8_SB(0, 0), cB, voffB); PG8_STAGE(PG8_SB(0, 1), cB + hstepB, voffB); PG8_STAGE(PG8_SA(0, 0), cA, voffA); PG8_STAGE(PG8_SA(0, 1), cA + hstepA, voffA);
    if (wr == 1) PG8_BAR;
    PG8_WAIT_V(2); PG8_BAR;
    PG8_STAGE(PG8_SB(1, 0), cB + kstep, voffB); PG8_STAGE(PG8_SA(1, 0), cA + kstep, voffA); PG8_STAGE(PG8_SB(1, 1), cB + hstepB + kstep, voffB);
    PG8_WAIT_V(6); PG8_BAR;
    for (;;) {
        const bool has_next = S.next(ui + 1, nxt);
        const char* nA = has_next ? S.aptr(nxt) : cA; const char* nB = has_next ? S.bptr(nxt) : cB;
        const auto pre = E.pre(cur, wr, fr);
#pragma unroll 1
        for (int t = 0; t < nt; t += 2) {
            const bool last = (t == nt - 2);
            const char* a1 = cA + (size_t)(t + 1) * kstep;
            const char* a2 = last ? nA : cA + (size_t)(t + 2) * kstep; const char* b2 = last ? nB : cB + (size_t)(t + 2) * kstep;
            const char* a3 = a2 + kstep; const char* b3 = b2 + kstep;
            const int rtail = (t == 0) ? ptail : 0;
            PG8_LDB(B0, 0, 0); PG8_LDB(B1, 0, 1); PG8_SCHED; PG8_LDA(At, 0, 0); PG8_STAGE(PG8_SA(1, 1), a1 + hstepA, voffA);
            PG8_WAIT_VR(rtail); PG8_WAIT_L(0); PG8_BAR; PG8_MMA(0, 0, At, B0); PG8_MMA(0, 1, At, B1); PG8_BAR; PG8_SCHED;
            PG8_LDA(At, 0, 1); PG8_STAGE(PG8_SB(0, 0), b2, voffB); PG8_STAGE(PG8_SB(0, 1), b2 + hstepB, voffB); PG8_STAGE(PG8_SA(0, 0), a2, voffA);
            PG8_WAIT_VR(rtail); PG8_WAIT_L(0); PG8_BAR; PG8_MMA(1, 0, At, B0); PG8_MMA(1, 1, At, B1); PG8_BAR; PG8_SCHED;
            PG8_LDB(B0, 1, 0); PG8_LDB(B1, 1, 1); PG8_SCHED; PG8_LDA(At, 1, 0); PG8_STAGE(PG8_SA(0, 1), a2 + hstepA, voffA);
            PG8_WAIT_V(8); PG8_WAIT_L(0); PG8_BAR; PG8_MMA(0, 0, At, B0); PG8_MMA(0, 1, At, B1); PG8_BAR; PG8_SCHED;
            PG8_LDA(At, 1, 1); PG8_STAGE(PG8_SB(1, 0), b3, voffB); PG8_STAGE(PG8_SB(1, 1), b3 + hstepB, voffB); PG8_STAGE(PG8_SA(1, 0), a3, voffA);
            PG8_WAIT_V(8); PG8_WAIT_L(0); PG8_BAR; PG8_MMA(1, 0, At, B0); PG8_MMA(1, 1, At, B1); PG8_BAR; PG8_SCHED;
        }
        if constexpr (ALIGN_EPI) { if (wr == 0) PG8_BAR; }
        E(acc, cur, S, wr, wc, fr, fq, pre);
        ptail = E.tail(cur);
        if (!has_next) break;
#pragma unroll
        for (int a = 0; a < 2; ++a)
#pragma unroll
            for (int b = 0; b < 2; ++b)
#pragma unroll
                for (int m = 0; m < 4; ++m)
#pragma unroll
                    for (int n = 0; n < 2; ++n) acc[a][b][m][n] = (f32x4){0.f, 0.f, 0.f, 0.f};
        cur = nxt; cA = nA; cB = nB; ++ui;
        if constexpr (ALIGN_EPI) { if (wr == 1) PG8_BAR; }
    }
    PG8_WAIT_V(0);
    if constexpr (!ALIGN_EPI) { if (wr == 0) PG8_BAR; }
    PG8_BAR;
#undef PG8_SA
#undef PG8_SB
#undef PG8_STAGE
#undef PG8_LDA
#undef PG8_LDB
#undef PG8_MMA
#undef PG8_WAIT_V
#undef PG8_WAIT_L
#undef PG8_WAIT_VR
#undef PG8_BAR
#undef PG8_SCHED
}
}

#define XB_TMO      128
#define XB_XCNT(j)  (256  + 64 * (j))
#define XB_XSUB(j)  (1280 + 64 * (j))
#define XB_XGEN(j)  (2304 + 64 * (j))
#define XB_TOP      3328
#define XB_TOPGEN   3392
#define XCD_BAR_WORDS 3456
#define XB_SPIN_CAP (1u << 18)
__device__ __forceinline__ unsigned xb_ld(unsigned* p)              { return __hip_atomic_load(p, __ATOMIC_RELAXED, __HIP_MEMORY_SCOPE_AGENT); }
__device__ __forceinline__ unsigned xb_add(unsigned* p, unsigned v) { return __hip_atomic_fetch_add(p, v, __ATOMIC_RELAXED, __HIP_MEMORY_SCOPE_AGENT); }
__device__ __forceinline__ unsigned xb_xcc_id() { return (unsigned)__builtin_amdgcn_s_getreg((3 << 11) | 20) & 0xFu; }
#define XB_SPIN(cond, bar) do { unsigned _sp = 0; while (cond) { __builtin_amdgcn_s_sleep(1); \
    if ((++_sp & 255u) == 0u) { if (xb_ld(&(bar)[XB_TMO])) break; if (_sp > XB_SPIN_CAP) { atomicAdd(&(bar)[XB_TMO], 1u); break; } } } } while (0)
struct XcdBarrier { unsigned* bar; unsigned x; volatile LAS unsigned* st; };
__device__ __forceinline__ XcdBarrier xcd_barrier_post(unsigned* bar, volatile LAS unsigned* st) {
    XcdBarrier b; b.bar = bar; b.x = xb_xcc_id(); b.st = st;
    if (threadIdx.x == 0) (void)xb_add(&bar[XB_XCNT(b.x)], 1u);
    return b;
}
__device__ __forceinline__ void xcd_barrier_complete(unsigned* bar, unsigned x, unsigned& nloc, unsigned& nx) {
    const unsigned G = gridDim.x * gridDim.y * gridDim.z;
    unsigned sum, cnt, mine, sp = 0u;
    for (;;) {
        sum = 0u; cnt = 0u; mine = 0u;
#pragma unroll
        for (unsigned j = 0; j < 16; ++j) { const unsigned c = xb_ld(&bar[XB_XCNT(j)]); sum += c; cnt += (c > 0u) ? 1u : 0u; mine = (j == x) ? c : mine; }
        if (sum == G) break;
        __builtin_amdgcn_s_sleep(1);
        if ((++sp & 255u) == 0u) { if (xb_ld(&bar[XB_TMO])) break; if (sp > XB_SPIN_CAP) { atomicAdd(&bar[XB_TMO], 1u); break; } }
    }
    nloc = mine > 0u ? mine : 1u; nx = cnt > 0u ? cnt : 1u;
}
__device__ __forceinline__ void xcd_barrier(const XcdBarrier& b) {
    asm volatile("s_waitcnt vmcnt(0)" ::: "memory");
    __syncthreads();
    if (threadIdx.x == 0) {
        unsigned* bar = b.bar;
        __builtin_amdgcn_s_waitcnt(0);
        unsigned nloc = b.st[0], nx = b.st[1];
        if (nloc == 0u) { xcd_barrier_complete(bar, b.x, nloc, nx); b.st[0] = nloc; b.st[1] = nx; }
        const unsigned old = xb_add(&bar[XB_XSUB(b.x)], 1u);
        const unsigned gen = old / nloc;
        if (old + 1u == (gen + 1u) * nloc) {
            __builtin_amdgcn_fence(__ATOMIC_RELEASE, "agent");
            asm volatile("s_waitcnt vmcnt(0)" ::: "memory");
            const unsigned og = xb_add(&bar[XB_TOP], 1u);
            const unsigned tg = og / nx;
            if (og + 1u == (tg + 1u) * nx) xb_add(&bar[XB_TOPGEN], 1u);
            else XB_SPIN(xb_ld(&bar[XB_TOPGEN]) == tg, bar);
            __builtin_amdgcn_fence(__ATOMIC_ACQUIRE, "agent");
            xb_add(&bar[XB_XGEN(b.x)], 1u);
            asm volatile("s_waitcnt vmcnt(0)" ::: "memory");
        } else {
            XB_SPIN(xb_ld(&bar[XB_XGEN(b.x)]) == gen, bar);
            __builtin_amdgcn_fence(__ATOMIC_ACQUIRE, "agent");
            asm volatile("s_waitcnt vmcnt(0)" ::: "memory");
        }
    }
    __syncthreads();
}

__device__ __forceinline__ void sub_barrier(unsigned* cnt, unsigned target) {
    asm volatile("s_waitcnt vmcnt(0)" ::: "memory");
    __syncthreads();
    if (threadIdx.x == 0) {
        __builtin_amdgcn_fence(__ATOMIC_RELEASE, "agent");
        asm volatile("s_waitcnt vmcnt(0)" ::: "memory");
        (void)xb_add(cnt, 1u);
        unsigned sp = 0u;
        while (xb_ld(cnt) < target) { __builtin_amdgcn_s_sleep(2); if (++sp > XB_SPIN_CAP) break; }
        __builtin_amdgcn_fence(__ATOMIC_ACQUIRE, "agent");
        asm volatile("s_waitcnt vmcnt(0)" ::: "memory");
    }
    __syncthreads();
}

constexpr int RING_OFF = 0, RING_BYTES = 131072;
constexpr int LDSCTL_OFF = 143360, MISC_OFF = LDSCTL_OFF + 320;
constexpr int LDS_BYTES = 147456;

using pg8::Unit;
template <int NM, int NN, int LDC, int OSZ, size_t ASTEP, size_t BSTEP>
struct SchedStd {
    int G, c; const char* A; const char* B; char* O;
    __device__ __forceinline__ bool next(int i, Unit& u) const { return pg8::tile_of(i, G, c, NM, NN, u.pm, u.pn); }
    __device__ __forceinline__ const char* aptr(const Unit& u) const { return A + (size_t)u.pm * ASTEP; }
    __device__ __forceinline__ const char* bptr(const Unit& u) const { return B + (size_t)u.pn * BSTEP; }
    __device__ __forceinline__ char* optr(const Unit& u) const { return O + ((size_t)u.pm * 256 * LDC + (size_t)u.pn * 256) * OSZ; }
    __device__ __forceinline__ int ldc(const Unit&) const { return LDC; }
};
struct SchedGU {
    int G, c; const char* A; const char* B; char* Gb; char* Ub;
    __device__ __forceinline__ bool next(int i, Unit& u) const { return pg8::tile_of(i, G, c, M / 256, 44, u.pm, u.pn); }
    __device__ __forceinline__ const char* aptr(const Unit& u) const { return A + (size_t)u.pm * 256 * DM * 2; }
    __device__ __forceinline__ const char* bptr(const Unit& u) const { return B + (size_t)u.pn * 256 * DM * 2; }
    __device__ __forceinline__ char* optr(const Unit& u) const { char* ob = u.pn < 22 ? Gb : Ub; const int pc = u.pn < 22 ? u.pn : u.pn - 22; return ob + ((size_t)u.pm * 256 * FF + (size_t)pc * 256) * 2; }
    __device__ __forceinline__ int ldc(const Unit&) const { return FF; }
};
struct SchedKV {
    int G, c; const char* MEMH; const char* W; char* KVX;
    __device__ __forceinline__ bool next(int i, Unit& u) const { const int id = i * G + c; if (id >= 256) return false; u.pm = id >> 4; u.pn = id & 15; return true; }
    __device__ __forceinline__ const char* aptr(const Unit& u) const { return MEMH + (size_t)u.pm * 256 * DM * 2; }
    __device__ __forceinline__ const char* bptr(const Unit& u) const { return W + (size_t)u.pn * 256 * DM * 2; }
    __device__ __forceinline__ char* optr(const Unit& u) const { return KVX + ((size_t)u.pm * 256 * 4096 + (size_t)u.pn * 256) * 2; }
    __device__ __forceinline__ int ldc(const Unit&) const { return 4096; }
};
struct SchedQK {
    int G, c; const char* KVX; const char* WQ; char* WQK;
    __device__ __forceinline__ bool next(int i, Unit& u) const { const int id = i * G + c; if (id >= 512) return false; u.pm = id >> 3; u.pn = id & 7; return true; }
    __device__ __forceinline__ const char* aptr(const Unit& u) const { return KVX + ((size_t)(u.pm >> 2) * 256 * 4096 + (size_t)(u.pm & 3) * 512) * 2; }
    __device__ __forceinline__ const char* bptr(const Unit& u) const { return WQ + ((size_t)u.pn * 256 * DM + (size_t)(u.pm & 3) * 512) * 2; }
    __device__ __forceinline__ char* optr(const Unit& u) const { return WQK + ((size_t)u.pm * 256 * DM + (size_t)u.pn * 256) * 2; }
    __device__ __forceinline__ int ldc(const Unit&) const { return DM; }
};
struct SchedOV {
    int G, c; const char* WOT; const char* KVX; char* WOV;
    __device__ __forceinline__ bool next(int i, Unit& u) const { const int id = i * G + c; if (id >= 512) return false; u.pm = id >> 3; u.pn = id & 7; return true; }
    __device__ __forceinline__ const char* aptr(const Unit& u) const { return WOT + ((size_t)u.pn * 256 * DM + (size_t)(u.pm & 3) * 512) * 2; }
    __device__ __forceinline__ const char* bptr(const Unit& u) const { return KVX + ((size_t)(u.pm >> 2) * 256 * 4096 + 2048 + (size_t)(u.pm & 3) * 512) * 2; }
    __device__ __forceinline__ char* optr(const Unit& u) const { return WOV + ((size_t)(u.pm >> 2) * 2048 * 1024 + (size_t)u.pn * 256 * 1024 + (size_t)(u.pm & 3) * 256) * 2; }
    __device__ __forceinline__ int ldc(const Unit&) const { return 1024; }
};
struct SchedS {
    int G, c; const char* HN; const char* WQK; char* P;
    __device__ __forceinline__ bool next(int i, Unit& u) const { return pg8::tile_of(i, G, c, M / 256, 4, u.pm, u.pn); }
    __device__ __forceinline__ const char* aptr(const Unit& u) const { return HN + (size_t)u.pm * 256 * DM * 2; }
    __device__ __forceinline__ const char* bptr(const Unit& u) const { return WQK + (size_t)((u.pm >> 3) * 4 + u.pn) * 256 * DM * 2; }
    __device__ __forceinline__ char* optr(const Unit& u) const { return P + ((size_t)u.pm * 256 * 1024 + (size_t)u.pn * 256) * 2; }
    __device__ __forceinline__ int ldc(const Unit&) const { return 1024; }
};
struct SchedXO {
    int G, c; const char* P; const char* WOV;
    __device__ __forceinline__ bool next(int i, Unit& u) const { return pg8::tile_of(i, G, c, M / 256, 8, u.pm, u.pn); }
    __device__ __forceinline__ const char* aptr(const Unit& u) const { return P + (size_t)u.pm * 256 * 1024 * 2; }
    __device__ __forceinline__ const char* bptr(const Unit& u) const { return WOV + ((size_t)(u.pm >> 3) * 2048 * 1024 + (size_t)u.pn * 256 * 1024) * 2; }
    __device__ __forceinline__ char* optr(const Unit&) const { return nullptr; }
    __device__ __forceinline__ int ldc(const Unit&) const { return DM; }
};
struct SchedWf {
    int G, c; const char* WMOT; const char* WPS; char* WF;
    __device__ __forceinline__ bool next(int i, Unit& u) const { const int id = i * G + c; if (id >= 32) return false; u.pn = id >> 3; u.pm = id & 7; return true; }
    __device__ __forceinline__ const char* aptr(const Unit& u) const { return WMOT + ((size_t)u.pm * 256 * 1024 + (size_t)u.pn * 256) * 2; }
    __device__ __forceinline__ const char* bptr(const Unit& u) const { return WPS + (size_t)u.pn * 65536 * 2; }
    __device__ __forceinline__ char* optr(const Unit& u) const { return WF + ((size_t)u.pm * 256 * DM + (size_t)u.pn * 256) * 2; }
    __device__ __forceinline__ int ldc(const Unit&) const { return DM; }
};
struct SchedP {
    int G, c; const char* A; const char* B; char* PB;
    __device__ __forceinline__ bool next(int i, Unit& u) const { return pg8::tile_of(i, G, c, M / 256, 20, u.pm, u.pn); }
    __device__ __forceinline__ const char* aptr(const Unit& u) const { return A + (size_t)u.pm * 256 * DM * 2; }
    __device__ __forceinline__ const char* bptr(const Unit& u) const { return B + (size_t)u.pn * 256 * DM * 2; }
    __device__ __forceinline__ char* optr(const Unit& u) const { return PB + ((size_t)u.pm * 256 * PW + (size_t)u.pn * 256) * 2; }
    __device__ __forceinline__ int ldc(const Unit&) const { return PW; }
};

typedef SchedStd<M / 256, 8, DM, 4, (size_t)256 * DM * 2, (size_t)256 * DM * 2> SchedX;
typedef SchedStd<M / 256, 8, DM, 2, (size_t)256 * DM * 2, (size_t)256 * DM * 2> SchedQ;
typedef SchedStd<M / 256, 8, DM, 4, (size_t)256 * FF * 2, (size_t)256 * FF * 2> SchedD;

struct Ctx { LAS unsigned char* lds; int tid, lane, wave, gw, NGW; };

__device__ __forceinline__ void transpose_item(const float* W, int K, int N, int ldw, bf16_t* WT, int ldt, LAS float* scr, int item, int lane, int rmode = 0, const float* gk = nullptr) {
    const int nblk = (N + 63) / 64, kb = item / nblk, nb = item % nblk, k0 = 64 * kb, n0 = 64 * nb;
    const int col4 = (lane & 15) * 4, r4 = lane >> 4; const bool nok = (n0 + col4) < N;
    f32x4 v[16];
#pragma unroll
    for (int i = 0; i < 16; ++i) v[i] = nok ? *(const GAS f32x4*)((const GAS float*)W + (size_t)(k0 + 4 * i + r4) * ldw + n0 + col4) : (f32x4){0.f, 0.f, 0.f, 0.f};
#pragma unroll
    for (int i = 0; i < 16; ++i) { const int kk = 4 * i + r4; *(LAS f32x4*)(scr + kk * 64 + ((col4 + 4 * (kk >> 3)) & 63)) = v[i]; }
    LDS_WAIT(); asm volatile("" ::: "memory");
    const int c = lane & 7;
    f32x4 ga = (f32x4){1.f, 1.f, 1.f, 1.f}, gb = ga;
    if (gk) { ga = *(const f32x4*)(gk + k0 + 8 * c); gb = *(const f32x4*)(gk + k0 + 8 * c + 4); }
#pragma unroll
    for (int j = 0; j < 8; ++j) { const int n = (lane >> 3) + 8 * j; const LAS float* s = scr + (8 * c) * 64 + ((n + 4 * c) & 63);
        u32x4 o; o.x = cvt_pk_bf16(s[0 * 64] * ga[0], s[1 * 64] * ga[1]); o.y = cvt_pk_bf16(s[2 * 64] * ga[2], s[3 * 64] * ga[3]); o.z = cvt_pk_bf16(s[4 * 64] * gb[0], s[5 * 64] * gb[1]); o.w = cvt_pk_bf16(s[6 * 64] * gb[2], s[7 * 64] * gb[3]);
        const int nn = n0 + n, rho = rmode == 0 ? nn : ((nn >> 7) * 256 + (nn & 127) + (rmode == 2 ? 128 : 0));
        if (nn < N) *(GAS u32x4*)((GAS bf16_t*)WT + (size_t)rho * ldt + k0 + 8 * c) = o; }
    LDS_WAIT(); asm volatile("" ::: "memory");
}

struct NormGain { f32x4 g[4][2]; };
__device__ __forceinline__ NormGain norm_gain(const Ctx& C, const float* gain) { NormGain G;
#pragma unroll
    for (int j = 0; j < 4; ++j) { G.g[j][0] = *(const f32x4*)(gain + (C.lane + 64 * j) * 8); G.g[j][1] = *(const f32x4*)(gain + (C.lane + 64 * j) * 8 + 4); }
    return G; }
__device__ __forceinline__ float sumsq8(const f32x4 a, const f32x4 b) { return ((a[0] * a[0] + a[1] * a[1]) + (a[2] * a[2] + a[3] * a[3])) + ((b[0] * b[0] + b[1] * b[1]) + (b[2] * b[2] + b[3] * b[3])); }
__device__ __forceinline__ u32x4 pack8n(const f32x4 a, const f32x4 b, const float r, const f32x4 ga, const f32x4 gb) { u32x4 w;
    w.x = cvt_pk_bf16(a[0] * r * ga[0], a[1] * r * ga[1]); w.y = cvt_pk_bf16(a[2] * r * ga[2], a[3] * r * ga[3]); w.z = cvt_pk_bf16(b[0] * r * gb[0], b[1] * r * gb[1]); w.w = cvt_pk_bf16(b[2] * r * gb[2], b[3] * r * gb[3]); return w; }
__device__ __forceinline__ void rmsnorm_rows_bf16(const Ctx& C, const bf16_t* x, const float* gain, bf16_t* dst, int nrows) {
    const NormGain G = norm_gain(C, gain);
    for (int m = C.gw; m < nrows; m += C.NGW) {
        const u32x4* xr = (const u32x4*)(x + (size_t)m * DM) + C.lane;
        u32x4 r[4]; f32x4 v[4][2]; float s = 0.f;
#pragma unroll
        for (int j = 0; j < 4; ++j) r[j] = xr[64 * j];
#pragma unroll
        for (int j = 0; j < 4; ++j) { v[j][0] = (f32x4){bflo(r[j].x), bfhi(r[j].x), bflo(r[j].y), bfhi(r[j].y)}; v[j][1] = (f32x4){bflo(r[j].z), bfhi(r[j].z), bflo(r[j].w), bfhi(r[j].w)}; s += sumsq8(v[j][0], v[j][1]); }
        const float rstd = rsqrtf(wave_sum(s) * (1.f / DM) + EPS);
        u32x4* o = (u32x4*)(dst + (size_t)m * DM) + C.lane;
#pragma unroll
        for (int j = 0; j < 4; ++j) o[64 * j] = pack8n(v[j][0], v[j][1], rstd, G.g[j][0], G.g[j][1]);
    }
}
template <bool COPY> __device__ __forceinline__ void rmsnorm_rows_first(const Ctx& C, const float* x, const float* gain, bf16_t* dst, bf16_t* xcopy, int nrows) {
    const NormGain G = norm_gain(C, gain);
    for (int m = C.gw; m < nrows; m += C.NGW) {
        const f32x4* xr = (const f32x4*)(x + (size_t)m * DM) + 2 * C.lane;
        f32x4 v[4][2]; float s = 0.f;
#pragma unroll
        for (int j = 0; j < 4; ++j) { v[j][0] = xr[128 * j]; v[j][1] = xr[128 * j + 1]; }
#pragma unroll
        for (int j = 0; j < 4; ++j) s += sumsq8(v[j][0], v[j][1]);
        const float rstd = rsqrtf(wave_sum(s) * (1.f / DM) + EPS);
        u32x4* o = (u32x4*)(dst + (size_t)m * DM) + C.lane; u32x4* xc = (u32x4*)(xcopy + (size_t)m * DM) + C.lane;
        const f32x4 one = (f32x4){1.f, 1.f, 1.f, 1.f};
#pragma unroll
        for (int j = 0; j < 4; ++j) { o[64 * j] = pack8n(v[j][0], v[j][1], rstd, G.g[j][0], G.g[j][1]); if (COPY) xc[64 * j] = pack8n(v[j][0], v[j][1], 1.0f, one, one); }
    }
}
__device__ __forceinline__ void x_first(const Ctx& C, const float* x, bf16_t* xcopy, float* rstd, int nrows) {
    for (int m = C.gw; m < nrows; m += C.NGW) {
        const f32x4* xr = (const f32x4*)(x + (size_t)m * DM) + 2 * C.lane;
        f32x4 v[4][2]; float s = 0.f;
#pragma unroll
        for (int j = 0; j < 4; ++j) { v[j][0] = xr[128 * j]; v[j][1] = xr[128 * j + 1]; }
#pragma unroll
        for (int j = 0; j < 4; ++j) s += sumsq8(v[j][0], v[j][1]);
        s = wave_sum(s);
        u32x4* xc = (u32x4*)(xcopy + (size_t)m * DM) + C.lane; const f32x4 one = (f32x4){1.f, 1.f, 1.f, 1.f};
#pragma unroll
        for (int j = 0; j < 4; ++j) xc[64 * j] = pack8n(v[j][0], v[j][1], 1.0f, one, one);
        if (C.lane == 0) rstd[m] = rsqrtf(s * (1.f / DM) + EPS);
    }
}
__device__ __forceinline__ void rstd_finish(const Ctx& C, const float* ssq, float* rstd, int nrows) {
    for (int m = C.gw * 64 + C.lane; m < nrows; m += C.NGW * 64) { const f32x4* p = (const f32x4*)(ssq + (size_t)m * 32); f32x4 t = p[0];
#pragma unroll
        for (int j = 1; j < 8; ++j) t = t + p[j];
        rstd[m] = rsqrtf(((t[0] + t[1]) + (t[2] + t[3])) * (1.f / DM) + EPS); }
}
__device__ __forceinline__ void rmsnorm_rows_f32(const Ctx& C, const bf16_t* x, float* out, const float* gain, int nrows) {
    const NormGain G = norm_gain(C, gain);
    for (int m = C.gw; m < nrows; m += C.NGW) {
        const u32x4* xr = (const u32x4*)(x + (size_t)m * DM) + C.lane;
        u32x4 r[4]; f32x4 v[4][2]; float s = 0.f;
#pragma unroll
        for (int j = 0; j < 4; ++j) r[j] = xr[64 * j];
#pragma unroll
        for (int j = 0; j < 4; ++j) { v[j][0] = (f32x4){bflo(r[j].x), bfhi(r[j].x), bflo(r[j].y), bfhi(r[j].y)}; v[j][1] = (f32x4){bflo(r[j].z), bfhi(r[j].z), bflo(r[j].w), bfhi(r[j].w)}; s += sumsq8(v[j][0], v[j][1]); }
        const float rstd = rsqrtf(wave_sum(s) * (1.f / DM) + EPS);
        f32x4* o = (f32x4*)(out + (size_t)m * DM) + 2 * C.lane;
#pragma unroll
        for (int j = 0; j < 4; ++j) { o[128 * j] = v[j][0] * rstd * G.g[j][0]; o[128 * j + 1] = v[j][1] * rstd * G.g[j][1]; }
    }
}

typedef short v4i16_t __attribute__((ext_vector_type(4)));
__device__ __forceinline__ u32x2 lds_tr16(const LAS unsigned char* p) {
    return __builtin_bit_cast(u32x2, __builtin_amdgcn_ds_read_tr16_b64_v4i16((LAS v4i16_t*)p)); }
__device__ __forceinline__ f32x4 mfma16(bf16x8 a, bf16x8 b, f32x4 c) { return __builtin_amdgcn_mfma_f32_16x16x32_bf16(a, b, c, 0, 0, 0); }
__device__ __forceinline__ bf16x8 pack8(const f32x4 lo, const f32x4 hi) { u32x4 w; w.x = cvt_pk_bf16_c(lo[0], lo[1]); w.y = cvt_pk_bf16_c(lo[2], lo[3]); w.z = cvt_pk_bf16_c(hi[0], hi[1]); w.w = cvt_pk_bf16_c(hi[2], hi[3]); return __builtin_bit_cast(bf16x8, w); }
__device__ __forceinline__ bf16x8 join8(const u32x2 lo, const u32x2 hi) { u32x4 w; w.x = lo.x; w.y = lo.y; w.z = hi.x; w.w = hi.y; return __builtin_bit_cast(bf16x8, w); }

__device__ __forceinline__ void logits16(const int lane_, const bf16_t* x, const bf16_t* wlt, const float* rstd, float* logit, const int blk) {
    int lane = lane_; asm volatile("" : "+v"(lane));
    const int c15 = lane & 15, g4 = lane >> 4;
    const GAS bf16_t* xa = (const GAS bf16_t*)x + (size_t)(16 * blk + c15) * DM + 8 * g4;
    const GAS bf16_t* wb = (const GAS bf16_t*)wlt + (size_t)c15 * DM + 8 * g4;
    f32x4 acc0 = (f32x4){0.f, 0.f, 0.f, 0.f}, acc1 = acc0;
#pragma unroll 1
    for (int k0 = 0; k0 < DM / 32; k0 += 16) {
        bf16x8 a[16], bb[16];
#pragma unroll
        for (int i = 0; i < 16; ++i) { a[i] = *(const GAS bf16x8*)(xa + 32 * (k0 + i)); bb[i] = *(const GAS bf16x8*)(wb + 32 * (k0 + i)); }
#pragma unroll
        for (int i = 0; i < 16; i += 2) { acc0 = mfma16(a[i], bb[i], acc0); acc1 = mfma16(a[i + 1], bb[i + 1], acc1); }
    }
    const f32x4 rs = *(const GAS f32x4*)((const GAS float*)rstd + 16 * blk + 4 * g4);
    const f32x4 v = (acc0 + acc1) * rs;
    GAS float* lp = (GAS float*)logit + (size_t)(16 * blk + 4 * g4) * 16 + c15;
#pragma unroll
    for (int r = 0; r < 4; ++r) lp[r * 16] = v[r];
}

template <int SEC> __device__ __forceinline__ void dn_conv_sec(const int lane, const unsigned zv, const bf16_t* pq, const float* cwq, bf16_t* dq, const bool seqstart) {
    const int c15 = lane & 15, g4 = lane >> 4;
    const GAS bf16_t* src = (const GAS bf16_t*)pq + (size_t)(16 * g4 - 3) * PW + SEC * 1024 + c15 * 8;
    GAS bf16_t* dst = (GAS bf16_t*)dq + (size_t)(16 * g4) * 3072 + SEC * 1024 + c15 * 8;
    const bool nohist = seqstart && g4 == 0;
    u32x4 raw[19];
#pragma unroll
    for (int i = 0; i < 19; ++i) { raw[i] = (u32x4){zv, zv, zv, zv}; if (i >= 3 || !nohist) raw[i] = *(const GAS u32x4*)(src + (size_t)i * PW); }
    constexpr float NL2E = -1.4426950408889634f, LN2 = 0.6931471805599453f;
    float wk[4][8];
#pragma unroll
    for (int k = 0; k < 4; ++k) { const f32x4 w0 = *(const GAS f32x4*)((const GAS float*)cwq + k * 3072 + SEC * 1024 + c15 * 8), w1 = *(const GAS f32x4*)((const GAS float*)cwq + k * 3072 + SEC * 1024 + c15 * 8 + 4);
        wk[k][0] = w0[0] * NL2E; wk[k][1] = w0[1] * NL2E; wk[k][2] = w0[2] * NL2E; wk[k][3] = w0[3] * NL2E; wk[k][4] = w1[0] * NL2E; wk[k][5] = w1[1] * NL2E; wk[k][6] = w1[2] * NL2E; wk[k][7] = w1[3] * NL2E; }
#define DN_UNPACK(d, q) do { d[0] = bflo(q.x); d[1] = bfhi(q.x); d[2] = bflo(q.y); d[3] = bfhi(q.y); d[4] = bflo(q.z); d[5] = bfhi(q.z); d[6] = bflo(q.w); d[7] = bfhi(q.w); } while (0)
    float p1[8], p2[8], p3[8];
    DN_UNPACK(p3, raw[0]); DN_UNPACK(p2, raw[1]); DN_UNPACK(p1, raw[2]);
#pragma unroll
    for (int i = 0; i < 16; ++i) {
        float c[8], u[8], ss = 0.f;
        DN_UNPACK(c, raw[i + 3]);
#pragma unroll
        for (int e = 0; e < 8; ++e) { const float yp = wk[3][e] * c[e] + wk[2][e] * p1[e] + wk[1][e] * p2[e] + wk[0][e] * p3[e];
            u[e] = yp * __builtin_amdgcn_rcpf(1.0f + __builtin_amdgcn_exp2f(yp)); ss += u[e] * u[e]; }
        float sc = -LN2;
        if (SEC < 2) { ss += sx<1>(ss); ss += sx<2>(ss); ss += sx<4>(ss); ss += sx<8>(ss); sc = -rsqrtf(ss + EPS * (NL2E * NL2E)) * (SEC == 0 ? 0.08838834764831845f : 1.0f); }
        u32x4 o; o.x = cvt_pk_bf16(u[0] * sc, u[1] * sc); o.y = cvt_pk_bf16(u[2] * sc, u[3] * sc); o.z = cvt_pk_bf16(u[4] * sc, u[5] * sc); o.w = cvt_pk_bf16(u[6] * sc, u[7] * sc);
        *(GAS u32x4*)(dst + (size_t)i * 3072) = o;
#pragma unroll
        for (int e = 0; e < 8; ++e) { p3[e] = p2[e]; p2[e] = p1[e]; p1[e] = c[e]; }
    }
#undef DN_UNPACK
}
__device__ __forceinline__ void dn_conv_qkv(const bf16_t* pq, const float* cwq, bf16_t* dq, const int m0) {
    unsigned zv = 0u; asm volatile("" : "+v"(zv));
    const int lane = (int)__builtin_amdgcn_mbcnt_hi(~0u, __builtin_amdgcn_mbcnt_lo(~0u, zv));
    const bool seqstart = (m0 & (SEQ - 1)) == 0;
    dn_conv_sec<0>(lane, zv, pq, cwq, dq, seqstart); asm volatile("" ::: "memory");
    dn_conv_sec<1>(lane, zv, pq, cwq, dq, seqstart); asm volatile("" ::: "memory");
    dn_conv_sec<2>(lane, zv, pq, cwq, dq, seqstart);
    asm volatile("s_waitcnt vmcnt(0)" ::: "memory");
}

__device__ __forceinline__ void dn_chunk_prep(const int wave, const unsigned lds_base, const bf16_t* qkv, const float* logit, const float nea, const float dtb, unsigned char* rec, const int m0, const int h) {
    unsigned zv = 0u; asm volatile("" : "+v"(zv));
    const int lane = (int)__builtin_amdgcn_mbcnt_hi(~0u, __builtin_amdgcn_mbcnt_lo(~0u, zv)); const float zf = __uint_as_float(zv);
    LAS unsigned char* scr; { unsigned sb = lds_base + (unsigned)wave * 17408u + zv; asm volatile("" : "+v"(sb)); scr = (LAS unsigned char*)(size_t)sb; }
    const int c15 = lane & 15, g4 = lane >> 4;
    LAS float* LtS = (LAS float*)scr;
    LAS float* GCs = (LAS float*)(scr + 16384);
    LAS float* BTs = GCs + 64;
    LAS float* BEs = BTs + 64;
    const GAS float* lgp = (const GAS float*)logit + (size_t)(m0 + lane) * 16 + h;
    const float blr = lgp[0], alr = lgp[8] + dtb;
    const float bl = 1.0f / (1.0f + __expf(-blr));
    float gc = nea * (fmaxf(alr, 0.f) + log1pf(__expf(-fabsf(alr))));
#pragma unroll
    for (int o = 1; o < 64; o <<= 1) { const float t = __builtin_bit_cast(float, __builtin_amdgcn_ds_bpermute((lane - o) << 2, __builtin_bit_cast(int, gc))); if (lane >= o) gc += t; }
    const float gcl = __builtin_bit_cast(float, __builtin_amdgcn_readlane(__builtin_bit_cast(int, gc), 63));
    GCs[lane] = gc; BTs[lane] = bl; BEs[lane] = bl * __expf(gc);
    asm volatile("" ::: "memory");
    { GAS float* mo = (GAS float*)(rec + REC_MISC); mo[lane] = __expf(gc); mo[64 + lane] = __expf(gcl - gc); if (lane == 0) mo[128] = __expf(gcl); }
    const GAS bf16_t* qb = (const GAS bf16_t*)qkv + (size_t)m0 * 3072 + h * 128;
    bf16x8 Kf[4][4], Qf[4][4];
#pragma unroll
    for (int rt = 0; rt < 4; ++rt)
#pragma unroll
        for (int ks = 0; ks < 4; ++ks) { Kf[rt][ks] = *(const GAS bf16x8*)(qb + (size_t)(16 * rt + c15) * 3072 + 1024 + 32 * ks + 8 * g4); Qf[rt][ks] = *(const GAS bf16x8*)(qb + (size_t)(16 * rt + c15) * 3072 + 32 * ks + 8 * g4); }
    float gcc[4];
    f32x4 gcr[4], btr[4];
#pragma unroll
    for (int t = 0; t < 4; ++t) { gcc[t] = GCs[16 * t + c15]; gcr[t] = *(const LAS f32x4*)(GCs + 16 * t + 4 * g4); btr[t] = *(const LAS f32x4*)(BTs + 16 * t + 4 * g4); }
#pragma unroll
    for (int jt = 0; jt < 4; ++jt)
#pragma unroll
        for (int ct = 0; ct <= jt; ++ct) {
            f32x4 d = (f32x4){0.f, 0.f, 0.f, 0.f};
#pragma unroll
            for (int ks = 0; ks < 4; ++ks) d = mfma16(Kf[jt][ks], Kf[ct][ks], d);
            const int c = 16 * ct + c15, j0 = 16 * jt + 4 * g4; f32x4 lv;
#pragma unroll
            for (int r = 0; r < 4; ++r) { lv[r] = btr[jt][r] * d[r] * __expf(fminf(gcr[jt][r] - gcc[ct], 0.f)); if (jt == ct && !(4 * g4 + r > c15)) lv[r] = 0.f; }
            if (jt >= 2 && ct < 2) { u32x2 w; w.x = cvt_pk_bf16(lv[0], lv[1]); w.y = cvt_pk_bf16(lv[2], lv[3]); *(LAS u32x2*)(scr + c * 256 + 128 + (j0 - 32) * 2) = w; }
            else *(LAS f32x4*)(LtS + c * 64 + j0) = lv;
        }
    { GAS bf16_t* ao = (GAS bf16_t*)(rec + REC_AT);
#pragma unroll
      for (int it = 0; it < 4; ++it) {
#pragma unroll
        for (int jt = 0; jt < 4; ++jt) {
            u32x2 w = (u32x2){zv, zv};
            if (it >= jt) {
                f32x4 d = (f32x4){0.f, 0.f, 0.f, 0.f};
#pragma unroll
                for (int ks = 0; ks < 4; ++ks) d = mfma16(Kf[jt][ks], Qf[it][ks], d);
                float v[4];
#pragma unroll
                for (int r = 0; r < 4; ++r) { v[r] = d[r] * __expf(fminf(gcc[it] - gcr[jt][r], 0.f)); if (it == jt && !(c15 >= 4 * g4 + r)) v[r] = 0.f; }
                w.x = cvt_pk_bf16(v[0], v[1]); w.y = cvt_pk_bf16(v[2], v[3]);
            }
            *(GAS u32x2*)(ao + (size_t)(16 * it + c15) * 64 + 16 * jt + 4 * g4) = w;
        } } }
#pragma unroll
    for (int jt = 0; jt < 3; jt += 2) *(LAS f32x4*)(LtS + (16 * (jt + 1) + c15) * 64 + 16 * jt + 4 * g4) = (f32x4){zf, zf, zf, zf};
    asm volatile("" ::: "memory");
    __builtin_amdgcn_sched_barrier(0);
    float T[32];
    LAS unsigned char* hp; { unsigned hb = lds_base + (unsigned)wave * 17408u + (unsigned)(lane >> 5) * 8320u; asm volatile("" : "+v"(hb)); hp = (LAS unsigned char*)(size_t)hb; }
    int lb = (lane & 31) * 4;
#pragma unroll
    for (int c = 31; c >= 0; --c) {
        if ((c & 7) == 7 && c < 31) asm volatile("" : "+v"(lb) : "v"(T[c + 1]) : "memory");
        float a0 = -*(const LAS float*)(hp + c * 256 + lb), a1 = 0.f;
#pragma unroll
        for (int q = 7; q >= (c + 1) / 4; --q) {
            const f32x4 lv = *(const LAS f32x4*)(hp + c * 256 + 16 * q);
#pragma unroll
            for (int e = 3; e >= 0; --e) { const int j = 4 * q + e; if (j > c) { if (j & 1) a1 = __builtin_fmaf(-T[j], lv[e], a1); else a0 = __builtin_fmaf(-T[j], lv[e], a0); } }
        }
        T[c] = a0 + a1;
    }
    __builtin_amdgcn_sched_barrier(0);
    asm volatile("" ::: "memory");
    int lane2 = lane; asm volatile("" : "+v"(lane2));
    const int c15b = lane2 & 15, g4b = lane2 >> 4, hf2 = lane2 >> 5, rl2 = lane2 & 31; float zf2 = zf; asm volatile("" : "+v"(zf2));
#pragma unroll
    for (int j8 = 0; j8 < 4; ++j8) { float v[8];
#pragma unroll
        for (int e = 0; e < 8; ++e) v[e] = (8 * j8 + e == rl2) ? 1.0f : T[8 * j8 + e];
        u32x4 w; w.x = cvt_pk_bf16(v[0], v[1]); w.y = cvt_pk_bf16(v[2], v[3]); w.z = cvt_pk_bf16(v[4], v[5]); w.w = cvt_pk_bf16(v[6], v[7]);
        *(LAS u32x4*)(scr + lane2 * 256 + hf2 * 128 + j8 * 16) = w; }
    asm volatile("" ::: "memory");
    f32x4 T21[2][2];
    { bf16x8 Al[2], Bt[2], A2[2];
#pragma unroll
      for (int t = 0; t < 2; ++t) { const LAS unsigned char* pB = scr + (8 * g4b + (c15b >> 2)) * 256 + (16 * t + 4 * (c15b & 3)) * 2;
          Bt[t] = join8(lds_tr16(pB), lds_tr16(pB + 4 * 256)); Al[t] = join8(lds_tr16(pB + 128), lds_tr16(pB + 128 + 4 * 256));
          const LAS unsigned char* pT = scr + (32 + 16 * t + c15b) * 256 + 128 + 8 * g4b; A2[t] = join8(*(const LAS u32x2*)pT, *(const LAS u32x2*)(pT + 32)); }
      f32x4 X[2][2];
#pragma unroll
      for (int jt = 0; jt < 2; ++jt)
#pragma unroll
          for (int ct = 0; ct < 2; ++ct) X[jt][ct] = mfma16(Al[jt], Bt[ct], (f32x4){0.f, 0.f, 0.f, 0.f});
#pragma unroll
      for (int ct = 0; ct < 2; ++ct) { const bf16x8 BX = pack8(X[0][ct], X[1][ct]);
#pragma unroll
          for (int it = 0; it < 2; ++it) T21[it][ct] = mfma16(A2[it], BX, (f32x4){0.f, 0.f, 0.f, 0.f}); } }
    u32x4 vst[16];
#pragma unroll
    for (int p = 0; p < 16; ++p) vst[p] = *(const GAS u32x4*)(qb + 2048 + (size_t)(4 * p + g4b) * 3072 + c15b * 8);
    asm volatile("s_waitcnt lgkmcnt(0)" ::: "memory");
    LAS bf16_t* TuS = (LAS bf16_t*)scr; LAS bf16_t* TwS = TuS + 64 * 64;
#pragma unroll
    for (int j8 = 0; j8 < 4; ++j8) {
        const LAS float* bp = BTs + 32 * hf2 + 8 * j8; const LAS float* ep = BEs + 32 * hf2 + 8 * j8;
        const f32x4 b0 = *(const LAS f32x4*)bp, b1 = *(const LAS f32x4*)(bp + 4), e0 = *(const LAS f32x4*)ep, e1 = *(const LAS f32x4*)(ep + 4);
        u32x4 wu, ww;
        wu.x = cvt_pk_bf16(T[8 * j8] * b0[0], T[8 * j8 + 1] * b0[1]); wu.y = cvt_pk_bf16(T[8 * j8 + 2] * b0[2], T[8 * j8 + 3] * b0[3]);
        wu.z = cvt_pk_bf16(T[8 * j8 + 4] * b1[0], T[8 * j8 + 5] * b1[1]); wu.w = cvt_pk_bf16(T[8 * j8 + 6] * b1[2], T[8 * j8 + 7] * b1[3]);
        ww.x = cvt_pk_bf16(-T[8 * j8] * e0[0], -T[8 * j8 + 1] * e0[1]); ww.y = cvt_pk_bf16(-T[8 * j8 + 2] * e0[2], -T[8 * j8 + 3] * e0[3]);
        ww.z = cvt_pk_bf16(-T[8 * j8 + 4] * e1[0], -T[8 * j8 + 5] * e1[1]); ww.w = cvt_pk_bf16(-T[8 * j8 + 6] * e1[2], -T[8 * j8 + 7] * e1[3]);
        *(LAS u32x4*)(TuS + lane2 * 64 + 32 * hf2 + 8 * j8) = wu; *(LAS u32x4*)(TwS + lane2 * 64 + 32 * hf2 + 8 * j8) = ww;
        if (hf2 == 0) { *(LAS u32x4*)(TuS + lane2 * 64 + 32 + 8 * j8) = (u32x4){zv, zv, zv, zv}; *(LAS u32x4*)(TwS + lane2 * 64 + 32 + 8 * j8) = (u32x4){zv, zv, zv, zv}; }
    }
#pragma unroll
    for (int ct = 0; ct < 2; ++ct) {
        const float nb = -BTs[16 * ct + c15b], pe = BEs[16 * ct + c15b];
#pragma unroll
        for (int it = 0; it < 2; ++it) { const f32x4 du = T21[it][ct] * nb, dw = T21[it][ct] * pe;
            const unsigned u01 = cvt_pk_bf16(du[0], du[1]), u23 = cvt_pk_bf16(du[2], du[3]), w01 = cvt_pk_bf16(dw[0], dw[1]), w23 = cvt_pk_bf16(dw[2], dw[3]);
            LAS unsigned short* pu = (LAS unsigned short*)(TuS + (32 + 16 * it + 4 * g4b) * 64 + 16 * ct + c15b); LAS unsigned short* pw = (LAS unsigned short*)(TwS + (32 + 16 * it + 4 * g4b) * 64 + 16 * ct + c15b);
            pu[0] = (unsigned short)(u01 & 0xffffu); pu[64] = (unsigned short)(u01 >> 16); pu[128] = (unsigned short)(u23 & 0xffffu); pu[192] = (unsigned short)(u23 >> 16);
            pw[0] = (unsigned short)(w01 & 0xffffu); pw[64] = (unsigned short)(w01 >> 16); pw[128] = (unsigned short)(w23 & 0xffffu); pw[192] = (unsigned short)(w23 >> 16); } }
    float btc[4], bec[4];
#pragma unroll
    for (int t = 0; t < 4; ++t) { btc[t] = BTs[16 * t + c15b]; bec[t] = -BEs[16 * t + c15b]; }
    asm volatile("" ::: "memory");
    bf16x8 Tuf[4][2], Twf[4][2];
#pragma unroll
    for (int it = 0; it < 4; ++it)
#pragma unroll
        for (int k2 = 0; k2 < 2; ++k2) { Tuf[it][k2] = *(const LAS bf16x8*)(TuS + (16 * it + c15b) * 64 + 32 * k2 + 8 * g4b); Twf[it][k2] = *(const LAS bf16x8*)(TwS + (16 * it + c15b) * 64 + 32 * k2 + 8 * g4b); }
#define DN_XT_PASS(TF, SCV, DSTOFF) do { GAS bf16_t* dst = (GAS bf16_t*)(rec + (DSTOFF)); \
        _Pragma("unroll") for (int et = 0; et < 8; ++et) { bf16x8 A[2]; \
            _Pragma("unroll") for (int k2 = 0; k2 < 2; ++k2) { const LAS unsigned char* p0 = scr + (32 * k2 + 8 * g4b + (c15b >> 2)) * 256 + (16 * et + 4 * (c15b & 3)) * 2; A[k2] = join8(lds_tr16(p0), lds_tr16(p0 + 4 * 256)); } \
            _Pragma("unroll") for (int it = 0; it < 4; ++it) { \
                const u32x2 xi = *(const LAS u32x2*)(scr + (16 * it + c15b) * 256 + (16 * et + 4 * g4b) * 2); const float sc = SCV[it]; \
                f32x4 d = (f32x4){sc * bflo(xi.x), sc * bfhi(xi.x), sc * bflo(xi.y), sc * bfhi(xi.y)}; \
                d = mfma16(A[0], TF[it][0], d); d = mfma16(A[1], TF[it][1], d); \
                d = d + zf2;                                    \
                u32x2 w; w.x = cvt_pk_bf16(d[0], d[1]); w.y = cvt_pk_bf16(d[2], d[3]); \
                *(GAS u32x2*)(dst + (size_t)(16 * it + c15b) * 128 + 16 * et + 4 * g4b) = w; } } } while (0)
    asm volatile("s_waitcnt lgkmcnt(0)" ::: "memory");
#pragma unroll
    for (int p = 0; p < 16; ++p) *(LAS u32x4*)(scr + p * 1024 + lane2 * 16) = vst[p];
    asm volatile("" ::: "memory");
    u32x4 kst[16];
#pragma unroll
    for (int p = 0; p < 16; ++p) kst[p] = *(const GAS u32x4*)(qb + 1024 + (size_t)(4 * p + g4b) * 3072 + c15b * 8);
    DN_XT_PASS(Tuf, btc, REC_U);
    asm volatile("s_waitcnt lgkmcnt(0)" ::: "memory");
#pragma unroll
    for (int p = 0; p < 16; ++p) *(LAS u32x4*)(scr + p * 1024 + lane2 * 16) = kst[p];
    asm volatile("" ::: "memory");
    DN_XT_PASS(Twf, bec, REC_NW);
#undef DN_XT_PASS
    asm volatile("s_waitcnt lgkmcnt(0)" ::: "memory");
}

constexpr int DN_P = 272, DN_PA = 144;
constexpr int DN_NW = 0, DN_Q = 64 * DN_P, DN_K = 2 * 64 * DN_P, DN_U = 3 * 64 * DN_P, DN_AT = 4 * 64 * DN_P, DN_MISC = DN_AT + 64 * DN_PA, DN_Z = DN_MISC + 1024, DN_SLOT = DN_Z + 64 * DN_P, DN_RSTD = DN_SLOT + 4096, DN_YT = DN_RSTD + 512, DN_LDS = DN_YT + 8 * 2048;
__device__ __forceinline__ void dn_scan(const int tid, LAS unsigned char* lds, const bf16_t* qkv, const unsigned char* recs, const bf16_t* pbuf, bf16_t* amix, const float* gnorm, const int b, const int h) {
    const int lane = tid & 63, w = __builtin_amdgcn_readfirstlane(tid >> 6), c15 = lane & 15, g4 = lane >> 4;
    f32x4 S[8];
#pragma unroll
    for (int dt = 0; dt < 8; ++dt) S[dt] = (f32x4){0.f, 0.f, 0.f, 0.f};
    const float gn = gnorm[16 * w + c15];
    f32x4 oprev[4]; u32x2 zprev[4];
#pragma unroll
    for (int rt = 0; rt < 4; ++rt) { oprev[rt] = (f32x4){0.f, 0.f, 0.f, 0.f}; zprev[rt] = (u32x2){0u, 0u}; }
    u32x4 rNW[2], rQ[2], rK[2], rU[2], rZ[2], rAT; float rM = 0.f;
    const unsigned char* rec0 = recs + (size_t)((b * 8 + h) * 32) * REC_BYTES;
#define DN_LOAD(n) do { const GAS unsigned char* rc = (const GAS unsigned char*)rec0 + (size_t)(n) * REC_BYTES; const GAS bf16_t* qb = (const GAS bf16_t*)qkv + (size_t)(b * SEQ + (n) * 64) * 3072 + h * 128; \
        const GAS bf16_t* zb = (const GAS bf16_t*)pbuf + (size_t)(b * SEQ + (n) * 64) * PW + 4096 + h * 128; \
        _Pragma("unroll") for (int i = 0; i < 2; ++i) { const int c = tid + 512 * i, row = c >> 4, col = c & 15; \
            rNW[i] = *(const GAS u32x4*)(rc + REC_NW + c * 16); rU[i] = *(const GAS u32x4*)(rc + REC_U + c * 16); rZ[i] = *(const GAS u32x4*)(zb + (size_t)row * PW + col * 8); \
            rQ[i] = *(const GAS u32x4*)(qb + (size_t)row * 3072 + col * 8); rK[i] = *(const GAS u32x4*)(qb + (size_t)row * 3072 + 1024 + col * 8); } \
        rAT = *(const GAS u32x4*)(rc + REC_AT + tid * 16); if (tid < 132) rM = ((const GAS float*)(rc + REC_MISC))[tid]; } while (0)
#define DN_RSTD(par) do { if (tid < 64) { const LAS float* sl = (const LAS float*)(lds + DN_SLOT) + (par) * 512 + tid; float t = 0.f; _Pragma("unroll") for (int ww = 0; ww < 8; ++ww) t += sl[ww * 64]; \
        ((LAS float*)(lds + DN_RSTD))[(par) * 64 + tid] = rsqrtf(t * (1.0f / 128.0f) + EPS); } } while (0)
#define DN_FINAL(par, nprev) do { LAS unsigned char* yt = lds + DN_YT + w * 2048; \
        _Pragma("unroll") for (int rt = 0; rt < 4; ++rt) { const f32x4 rs = *(const LAS f32x4*)((const LAS float*)(lds + DN_RSTD) + (par) * 64 + 16 * rt + 4 * g4); \
            const float zz[4] = {bflo(zprev[rt].x), bfhi(zprev[rt].x), bflo(zprev[rt].y), bfhi(zprev[rt].y)}; \
            _Pragma("unroll") for (int r = 0; r < 4; ++r) { const float y = oprev[rt][r] * rs[r] * gn * silu_f(zz[r]); \
                *(LAS unsigned short*)(yt + (16 * rt + 4 * g4 + r) * 32 + c15 * 2) = (unsigned short)(cvt_pk_bf16_c(y, 0.f) & 0xffffu); } } \
        asm volatile("s_waitcnt lgkmcnt(0)" ::: "memory");            \
        GAS bf16_t* yb = (GAS bf16_t*)amix + (size_t)(b * SEQ + (nprev) * 64) * DM + 1024 + h * 128 + 16 * w; \
        _Pragma("unroll") for (int j = 0; j < 2; ++j) { const int tk = (lane >> 1) + 32 * j, hf = lane & 1; \
            const u32x4 v = *(const LAS u32x4*)(yt + tk * 32 + hf * 16); *(GAS u32x4*)(yb + (size_t)tk * DM + 8 * hf) = v; } \
        asm volatile("" ::: "memory"); } while (0)
    DN_LOAD(0);
#pragma unroll 1
    for (int n = 0; n < SEQ / 64; ++n) {
        __syncthreads();
#pragma unroll
        for (int i = 0; i < 2; ++i) { const int c = tid + 512 * i, row = c >> 4, col = c & 15; const int o = row * DN_P + col * 16;
            *(LAS u32x4*)(lds + DN_NW + o) = rNW[i]; *(LAS u32x4*)(lds + DN_Q + o) = rQ[i]; *(LAS u32x4*)(lds + DN_K + o) = rK[i]; *(LAS u32x4*)(lds + DN_U + o) = rU[i]; *(LAS u32x4*)(lds + DN_Z + o) = rZ[i]; }
        *(LAS u32x4*)(lds + DN_AT + (tid >> 3) * DN_PA + (tid & 7) * 16) = rAT;
        if (tid < 132) ((LAS float*)(lds + DN_MISC))[tid] = rM;
        if (n > 0) DN_RSTD((n - 1) & 1);
        __syncthreads();
        if (n + 1 < SEQ / 64) DN_LOAD(n + 1);
        if (n > 0) DN_FINAL((n - 1) & 1, n - 1);
        const LAS float* ms = (const LAS float*)(lds + DN_MISC);
        const float cdec = ms[128];
        bf16x8 BS[4];
#pragma unroll
        for (int ks = 0; ks < 4; ++ks) BS[ks] = pack8(S[2 * ks], S[2 * ks + 1]);
#define DN_APERM(off, pitch, rt, ks) join8(*(const LAS u32x2*)(lds + (off) + (16 * (rt) + c15) * (pitch) + (32 * (ks) + 4 * g4) * 2), *(const LAS u32x2*)(lds + (off) + (16 * (rt) + c15) * (pitch) + (32 * (ks) + 16 + 4 * g4) * 2))
        f32x4 vn[4], oq[4];
#pragma unroll
        for (int rt = 0; rt < 4; ++rt) { const u32x2 uu = lds_tr16(lds + DN_U + (16 * rt + 4 * g4 + (c15 >> 2)) * DN_P + (16 * w + 4 * (c15 & 3)) * 2);
            zprev[rt] = lds_tr16(lds + DN_Z + (16 * rt + 4 * g4 + (c15 >> 2)) * DN_P + (16 * w + 4 * (c15 & 3)) * 2);
            vn[rt] = (f32x4){bflo(uu.x), bfhi(uu.x), bflo(uu.y), bfhi(uu.y)}; oq[rt] = (f32x4){0.f, 0.f, 0.f, 0.f}; }
        { bf16x8 an[4], aq[4];
#pragma unroll
          for (int ks = 0; ks < 4; ++ks) {
#pragma unroll
              for (int rt = 0; rt < 4; ++rt) { an[rt] = DN_APERM(DN_NW, DN_P, rt, ks); aq[rt] = DN_APERM(DN_Q, DN_P, rt, ks); }
              __builtin_amdgcn_sched_barrier(0);
#pragma unroll
              for (int rt = 0; rt < 4; ++rt) { vn[rt] = mfma16(an[rt], BS[ks], vn[rt]); oq[rt] = mfma16(aq[rt], BS[ks], oq[rt]); }
              __builtin_amdgcn_sched_barrier(0);
          } }
        bf16x8 BV[2];
#pragma unroll
        for (int k2 = 0; k2 < 2; ++k2) BV[k2] = pack8(vn[2 * k2], vn[2 * k2 + 1]);
        f32x4 oa[4];
        { bf16x8 at[4][2];
#pragma unroll
          for (int rt = 0; rt < 4; ++rt)
#pragma unroll
              for (int k2 = 0; k2 < 2; ++k2) at[rt][k2] = DN_APERM(DN_AT, DN_PA, rt, k2);
          __builtin_amdgcn_sched_barrier(0);
#pragma unroll
          for (int rt = 0; rt < 4; ++rt) { oa[rt] = (f32x4){0.f, 0.f, 0.f, 0.f};
#pragma unroll
              for (int k2 = 0; k2 < 2; ++k2) oa[rt] = mfma16(at[rt][k2], BV[k2], oa[rt]); }
          __builtin_amdgcn_sched_barrier(0); }
        float q16[16];
#pragma unroll
        for (int rt = 0; rt < 4; ++rt) { const f32x4 eg = *(const LAS f32x4*)(ms + 16 * rt + 4 * g4), ek = *(const LAS f32x4*)(ms + 64 + 16 * rt + 4 * g4);
#pragma unroll
            for (int r = 0; r < 4; ++r) { const float o = eg[r] * oq[rt][r] + oa[rt][r]; oprev[rt][r] = o; q16[4 * rt + r] = o * o; }
            vn[rt] = vn[rt] * ek; }
        {
            float q8[8], q4[4], q2[2];
            const bool b0 = c15 & 1, b1 = c15 & 2, b2 = c15 & 4, b3 = c15 & 8;
#pragma unroll
            for (int k = 0; k < 8; ++k) { const float a = q16[2 * k], bb = q16[2 * k + 1]; q8[k] = (b0 ? bb : a) + sx<1>(b0 ? a : bb); }
#pragma unroll
            for (int k = 0; k < 4; ++k) { const float a = q8[2 * k], bb = q8[2 * k + 1]; q4[k] = (b1 ? bb : a) + sx<2>(b1 ? a : bb); }
#pragma unroll
            for (int k = 0; k < 2; ++k) { const float a = q4[2 * k], bb = q4[2 * k + 1]; q2[k] = (b2 ? bb : a) + sx<4>(b2 ? a : bb); }
            const float q1 = (b3 ? q2[1] : q2[0]) + sx<8>(b3 ? q2[0] : q2[1]);
            ((LAS float*)(lds + DN_SLOT))[(n & 1) * 512 + w * 64 + 16 * (c15 >> 2) + 4 * g4 + (c15 & 3)] = q1;
        }
#pragma unroll
        for (int k2 = 0; k2 < 2; ++k2) BV[k2] = pack8(vn[2 * k2], vn[2 * k2 + 1]);
        { bf16x8 kf[4][2];
#define DN_KF(dt, k2) join8(lds_tr16(lds + DN_K + (32 * (k2) + 4 * g4 + (c15 >> 2)) * DN_P + (16 * (dt) + 4 * (c15 & 3)) * 2), lds_tr16(lds + DN_K + (32 * (k2) + 4 * g4 + (c15 >> 2)) * DN_P + (16 * (dt) + 4 * (c15 & 3)) * 2 + 16 * DN_P))
#pragma unroll
          for (int hb = 0; hb < 2; ++hb) {
#pragma unroll
              for (int d4 = 0; d4 < 4; ++d4)
#pragma unroll
                  for (int k2 = 0; k2 < 2; ++k2) kf[d4][k2] = DN_KF(4 * hb + d4, k2);
              __builtin_amdgcn_sched_barrier(0);
#pragma unroll
              for (int d4 = 0; d4 < 4; ++d4) { f32x4 acc = S[4 * hb + d4] * cdec;
#pragma unroll
                  for (int k2 = 0; k2 < 2; ++k2) acc = mfma16(kf[d4][k2], BV[k2], acc);
                  S[4 * hb + d4] = acc; }
              __builtin_amdgcn_sched_barrier(0);
          }
#undef DN_KF
        }
    }
    __syncthreads();
    DN_RSTD((SEQ / 64 - 1) & 1);
    __syncthreads();
    DN_FINAL((SEQ / 64 - 1) & 1, SEQ / 64 - 1);
#undef DN_LOAD
#undef DN_APERM
#undef DN_RSTD
#undef DN_FINAL
    __syncthreads();
}

#define PHASE_BEGIN() unsigned char* wsl = ws; int bx = bx0; int G = G0; long zoff = 0; Ctx C = C0; asm volatile("" : "+s"(wsl), "+s"(bx), "+s"(G), "+s"(zoff), "+s"(C.wave), "+s"(C.gw), "+s"(C.NGW)); { unsigned zv = 0u; asm volatile("" : "+v"(zv)); C.lane = (int)__builtin_amdgcn_mbcnt_hi(~0u, __builtin_amdgcn_mbcnt_lo(~0u, zv)); } C.tid = C.wave * 64 + C.lane
#define INP(k) (a.in[k] + zoff)
#define MEMH ((bf16_t*)(wsl + WS_MEMH))
#define KVX ((bf16_t*)(wsl + WS_KX))
#define WinT ((bf16_t*)(wsl + WS_WIN))
#define WfT ((bf16_t*)(wsl + WS_WF))
#define WmoT ((bf16_t*)(wsl + WS_WMOT))
#define WpS ((bf16_t*)(wsl + WS_WPS))
#define WxqP ((bf16_t*)(wsl + WS_WXQ))
#define WxkvT ((bf16_t*)(wsl + WS_WXKV))
#define WxoT ((bf16_t*)(wsl + WS_WXO))
#define WguT ((bf16_t*)(wsl + WS_WGU))
#define WdT ((bf16_t*)(wsl + WS_WD))
#define LOGIT ((float*)(wsl + WS_LOGIT))
#define BETA ((float*)(wsl + WS_BETA))
#define GDEC ((float*)(wsl + WS_GDEC))
#define H ((bf16_t*)(wsl + WS_H))
#define AMIX ((bf16_t*)(wsl + WS_H))
#define PBUF ((bf16_t*)(wsl + WS_PBUF))
#define QKVN ((bf16_t*)(wsl + WS_QKVN))
#define SSQ ((float*)(wsl + WS_SSQ))
#define RSTD ((float*)(wsl + WS_RSTD))
#define XB ((bf16_t*)(wsl + WS_ODN))
#define WQK ((bf16_t*)(wsl + WS_WQK))
#define WOV ((bf16_t*)(wsl + WS_WOV))
#define PATT ((bf16_t*)(wsl + WS_PATT))
#define GB ((bf16_t*)(wsl + WS_G))
#define UB ((bf16_t*)(wsl + WS_U))
#define HALOG ((float*)(wsl + WS_HALO))
#define FIXG ((float*)(wsl + WS_FIXG))
#define FIXU ((float*)(wsl + WS_FIXU))

struct Args { const float* in[23]; float* out; unsigned char* ws; int l_lo, l_hi, ph_lo, ph_hi; int single, pad; };
constexpr int NPH = 18;

__global__ void __launch_bounds__(NTHR, 2) fwd_kernel(Args a) {
    extern __shared__ __attribute__((aligned(16))) unsigned char lds_raw[];
    LAS unsigned char* lds = (LAS unsigned char*)lds_raw;
    Ctx C0; C0.lds = lds; C0.tid = 0; C0.lane = 0; C0.wave = __builtin_amdgcn_readfirstlane(threadIdx.x >> 6);
    const int G0 = gridDim.x; const int bx0 = blockIdx.x; const int vcu = (G0 % 8 == 0) ? (bx0 % 8) * (G0 / 8) + bx0 / 8 : bx0;
    C0.gw = vcu * NWAVES + C0.wave; C0.NGW = G0 * NWAVES;
    unsigned char* ws = a.ws;
    unsigned* ctl = (unsigned*)(ws + WS_CTL);
    volatile LAS unsigned* MISC = (volatile LAS unsigned*)(lds + MISC_OFF);
    for (int u = threadIdx.x; u < (LDS_BYTES - LDSCTL_OFF) / 4; u += NTHR) ((LAS unsigned*)(lds + LDSCTL_OFF))[u] = 0u;
    __syncthreads();
    XcdBarrier bar; bar.bar = ctl + CW_BAR; bar.x = 0; bar.st = nullptr;
    if (a.single) bar = xcd_barrier_post(ctl + CW_BAR, MISC + 8);
#define SEAM() do { if (a.single) xcd_barrier(bar); } while (0)
#ifndef PH_MASK
#define PH_MASK 0x3ffff
#endif
#ifndef PROBE_MASK
#define PROBE_MASK 0
#endif
#define REPS(k) (1 + (((PROBE_MASK) >> (k)) & 1))
#define IN(k) ((((PH_MASK) >> (k)) & 1) && a.ph_lo <= (k) && (k) < a.ph_hi)


    for (int l = a.l_lo; l < a.l_hi; ++l) {

        if (IN(0)) for (int rep_ = 0; rep_ < REPS(0); ++rep_) { PHASE_BEGIN();
            LAS float* scr = (LAS float*)(lds + RING_OFF + C.wave * 16384);
            const float* w_in = INP(3) + (size_t)l * DM * INW; const float* w_mo = INP(10) + (size_t)l * DM * DM;
            const float* w_xq = INP(13) + (size_t)l * DM * DM; const float* w_xkv = INP(14) + (size_t)l * DM * 2 * DM; const float* w_xo = INP(15) + (size_t)l * DM * DM;
            const float* w_g = INP(17) + (size_t)l * DM * FF; const float* w_u = INP(18) + (size_t)l * DM * FF; const float* w_d = INP(21) + (size_t)l * FF * DM;
            constexpr int I_IN = (DM / 64) * ((INW + 63) / 64), I_MO1 = (1024 / 64) * (DM / 64), I_MO2 = I_MO1, I_XQ = (DM / 64) * (DM / 64), I_XKV = (DM / 64) * (2 * DM / 64), I_XO = I_XQ,
                          I_G = (DM / 64) * (FF / 64), I_U = I_G, I_D = (FF / 64) * (DM / 64);
            constexpr int NITEMS = I_IN + I_MO1 + I_MO2 + I_XKV + I_XO;
            for (int it = C.gw; it < NITEMS; it += C.NGW) {
                int r = it;
                if (r < I_IN) { transpose_item(w_in, DM, INW, INW, WinT, DM, scr, r, C.lane, 0, INP(2) + (size_t)l * DM); continue; } r -= I_IN;
                if (r < I_MO1) { transpose_item(w_mo, 1024, DM, DM, WmoT, 1024, scr, r, C.lane); continue; } r -= I_MO1;
                if (r < I_MO2) { transpose_item(w_mo + (size_t)1024 * DM, 1024, DM, DM, WfT + 1024, DM, scr, r, C.lane); continue; } r -= I_MO2;

                if (r < I_XKV) { transpose_item(w_xkv, DM, 2 * DM, 2 * DM, WxkvT, DM, scr, r, C.lane); continue; } r -= I_XKV;
                transpose_item(w_xo, DM, DM, DM, WxoT, DM, scr, r, C.lane);
            }
            {
                const float* g2 = INP(11) + (size_t)l * DM;
                for (size_t i = (size_t)(C.gw * 64 + C.lane) * 8; i < (size_t)DM * DM; i += (size_t)C.NGW * 64 * 8) { const f32x4 a = *(const f32x4*)(w_xq + i), bq = *(const f32x4*)(w_xq + i + 4); const float gg = g2[i >> 11];
                    u32x4 o; o.x = cvt_pk_bf16(a[0] * gg, a[1] * gg); o.y = cvt_pk_bf16(a[2] * gg, a[3] * gg); o.z = cvt_pk_bf16(bq[0] * gg, bq[1] * gg); o.w = cvt_pk_bf16(bq[2] * gg, bq[3] * gg); *(u32x4*)(WxqP + i) = o; }
            }
            {
                const float* wp = INP(4) + (size_t)l * 4 * 65536; const float* ps = INP(5) + (size_t)l * 1024;
                for (int i = (C.gw * 64 + C.lane) * 4; i < 4 * 65536; i += C.NGW * 64 * 4) {
                    const f32x4 w = *(const f32x4*)(wp + i); const int g = i >> 16, j = i & 255; const f32x4 s = *(const f32x4*)(ps + g * 256 + j);
                    u32x2 o; o.x = cvt_pk_bf16(w[0] * s[0], w[1] * s[1]); o.y = cvt_pk_bf16(w[2] * s[2], w[3] * s[3]); *(u32x2*)(WpS + i) = o; }
            }
            if (l == 0) rmsnorm_rows_first<false>(C, INP(1), INP(12), MEMH, MEMH, MM);
            if (l == 0) x_first(C, INP(0), XB, RSTD, M); else rstd_finish(C, SSQ, RSTD, M);
            SEAM();
        }
        if (IN(1)) for (int rep_ = 0; rep_ < REPS(1); ++rep_) { PHASE_BEGIN();
            { SchedP S{G, bx, (const char*)XB, (const char*)WinT, (char*)PBUF}; pg8::EpiP E{LOGIT, RSTD};
              pg8::gemm_phase<pg8::Gemm<DM, DM, DM>, pg8::EpiP, SchedP, true>(lds + RING_OFF, C.tid, S, E); }
            for (int blk = C.gw; blk < M / 16; blk += C.NGW) logits16(C.lane, XB, WinT + (size_t)PW * DM, RSTD, LOGIT, blk);
            SEAM();
        }
        if (IN(2)) for (int rep_ = 0; rep_ < REPS(2); ++rep_) { PHASE_BEGIN();
            const float* cw = INP(6) + (size_t)l * 4 * 3072;
#pragma unroll 1
            for (int task_ = C.gw; task_ < (M / 32) * 2; task_ += C.NGW) {
                const int task = (M / 32) * 2 - 1 - task_;
                const int run = task >> 1, sl = 6 + (task & 1), m0 = run * 32, t0 = m0 & (SEQ - 1);
                if (sl < 6) {
                    const int c0 = sl * 512 + C.lane * 8;
                    const GAS bf16_t* src = (const GAS bf16_t*)PBUF + (size_t)m0 * PW + 1024 + c0; GAS bf16_t* dst = (GAS bf16_t*)QKVN + (size_t)m0 * 3072 + c0;
                    float wk[4][8];
#pragma unroll
                    for (int k = 0; k < 4; ++k) { const f32x4 w0 = *(const f32x4*)(cw + k * 3072 + c0), w1 = *(const f32x4*)(cw + k * 3072 + c0 + 4);
                        wk[k][0] = w0[0]; wk[k][1] = w0[1]; wk[k][2] = w0[2]; wk[k][3] = w0[3]; wk[k][4] = w1[0]; wk[k][5] = w1[1]; wk[k][6] = w1[2]; wk[k][7] = w1[3]; }
                    u32x4 x1 = (u32x4){0u, 0u, 0u, 0u}, x2 = x1, x3 = x1;
                    if (t0 > 0) { x1 = *(const GAS u32x4*)(src - (size_t)PW); x2 = *(const GAS u32x4*)(src - (size_t)2 * PW); x3 = *(const GAS u32x4*)(src - (size_t)3 * PW); }
                    const float qsc = sl < 2 ? 0.08838834764831845f : 1.0f;
#pragma unroll 1
                    for (int tb = 0; tb < 32; tb += 4) {
                        u32x4 xn[4];
#pragma unroll
                        for (int i = 0; i < 4; ++i) xn[i] = *(const GAS u32x4*)(src + (size_t)(tb + i) * PW);
#pragma unroll
                        for (int i = 0; i < 4; ++i) {
                            const u32x4 x0 = xn[i]; float y[8];
                            const unsigned a0[4] = {x0.x, x0.y, x0.z, x0.w}, a1[4] = {x1.x, x1.y, x1.z, x1.w}, a2[4] = {x2.x, x2.y, x2.z, x2.w}, a3[4] = {x3.x, x3.y, x3.z, x3.w};
#pragma unroll
                            for (int e = 0; e < 4; ++e) {
                                y[2 * e] = wk[3][2 * e] * bflo(a0[e]) + wk[2][2 * e] * bflo(a1[e]) + wk[1][2 * e] * bflo(a2[e]) + wk[0][2 * e] * bflo(a3[e]);
                                y[2 * e + 1] = wk[3][2 * e + 1] * bfhi(a0[e]) + wk[2][2 * e + 1] * bfhi(a1[e]) + wk[1][2 * e + 1] * bfhi(a2[e]) + wk[0][2 * e + 1] * bfhi(a3[e]); }
                            float ss = 0.f;
#pragma unroll
                            for (int e = 0; e < 8; ++e) { y[e] = silu_f(y[e]); ss += y[e] * y[e]; }
                            float sc = 1.0f;
                            if (sl < 4) { ss += sx<1>(ss); ss += sx<2>(ss); ss += sx<4>(ss); ss += sx<8>(ss); sc = rsqrtf(ss + EPS) * qsc; }
                            u32x4 o; o.x = cvt_pk_bf16(y[0] * sc, y[1] * sc); o.y = cvt_pk_bf16(y[2] * sc, y[3] * sc); o.z = cvt_pk_bf16(y[4] * sc, y[5] * sc); o.w = cvt_pk_bf16(y[6] * sc, y[7] * sc);
                            *(GAS u32x4*)(dst + (size_t)(tb + i) * 3072) = o;
                            x3 = x2; x2 = x1; x1 = x0;
                        }
                    }
                } else {
                    const int c0 = (sl - 6) * 512 + C.lane * 8, w = 2 << (2 * (sl - 6) + (C.lane >> 5));
                    const GAS bf16_t* src = (const GAS bf16_t*)PBUF + (size_t)m0 * PW + c0; GAS bf16_t* dst = (GAS bf16_t*)AMIX + (size_t)m0 * DM + c0;
                    float S[8];
#pragma unroll
                    for (int e = 0; e < 8; ++e) S[e] = 0.f;
                    for (int i = 1; i <= 16; ++i) {
                        if (i <= w && t0 - i >= 0) { const u32x4 q = *(const GAS u32x4*)(src - (size_t)i * PW); const unsigned a[4] = {q.x, q.y, q.z, q.w};
#pragma unroll
                            for (int e = 0; e < 4; ++e) { S[2 * e] += bflo(a[e]); S[2 * e + 1] += bfhi(a[e]); } } }
#pragma unroll 1
                    for (int tb = 0; tb < 32; tb += 4) {
                        u32x4 xn[4], xl[4];
#pragma unroll
                        for (int i = 0; i < 4; ++i) { xn[i] = *(const GAS u32x4*)(src + (size_t)(tb + i) * PW);
                            xl[i] = (t0 + tb + i - w >= 0) ? *(const GAS u32x4*)(src + (size_t)(tb + i - w) * PW) : (u32x4){0u, 0u, 0u, 0u}; }
#pragma unroll
                        for (int i = 0; i < 4; ++i) {
                            const int t = t0 + tb + i; const float inv = 1.0f / (float)((t + 1) < w ? (t + 1) : w);
                            const unsigned a[4] = {xn[i].x, xn[i].y, xn[i].z, xn[i].w}, b[4] = {xl[i].x, xl[i].y, xl[i].z, xl[i].w}; unsigned o[4];
#pragma unroll
                            for (int e = 0; e < 4; ++e) { const float u0 = bflo(a[e]), u1 = bfhi(a[e]); S[2 * e] += u0 - bflo(b[e]); S[2 * e + 1] += u1 - bfhi(b[e]);
                                o[e] = cvt_pk_bf16(S[2 * e] * inv - u0, S[2 * e + 1] * inv - u1); }
                            *(GAS u32x4*)(dst + (size_t)(tb + i) * DM) = (u32x4){o[0], o[1], o[2], o[3]};
                        }
                    }
                }
            }
        }
        if (IN(3)) for (int rep_ = 0; rep_ < REPS(3); ++rep_) { PHASE_BEGIN();
#pragma unroll 1
            for (int task = C.gw; task < BATCH * 8 * (SEQ / 64); task += C.NGW) {
                const int bh = task >> 5, n = task & 31, b = bh >> 3, h = bh & 7;
                dn_conv_qkv(PBUF + (size_t)(b * SEQ + n * 64) * PW + 1024 + h * 128, INP(6) + (size_t)l * 4 * 3072 + h * 128, QKVN + (size_t)(b * SEQ + n * 64) * 3072 + h * 128, b * SEQ + n * 64);
                dn_chunk_prep(C.wave, (unsigned)(size_t)lds, QKVN, LOGIT, -__expf(INP(7)[l * 8 + h]), INP(8)[l * 8 + h], wsl + WS_REC + (size_t)task * REC_BYTES, b * SEQ + n * 64, h);
            }
            {
                LAS float* scr = (LAS float*)(lds + C.wave * 17408);
                const float* w_g = INP(17) + (size_t)l * DM * FF; const float* w_u = INP(18) + (size_t)l * DM * FF; const float* w_d = INP(21) + (size_t)l * FF * DM;
                constexpr int I_G = (DM / 64) * (FF / 64), I_U = I_G, I_D = (FF / 64) * (DM / 64);
                for (int it = C.gw; it < I_G + I_U + I_D; it += C.NGW) {
                    int r = it;
                    if (r < I_G) { transpose_item(w_g, DM, FF, FF, WguT, DM, scr, r, C.lane, 1, INP(16) + (size_t)l * DM); continue; } r -= I_G;
                    if (r < I_U) { transpose_item(w_u, DM, FF, FF, WguT, DM, scr, r, C.lane, 2, INP(16) + (size_t)l * DM); continue; } r -= I_U;
                    transpose_item(w_d, FF, DM, DM, WdT, FF, scr, r, C.lane);
                }
            }
            SEAM();
        }
        if (IN(4)) for (int rep_ = 0; rep_ < REPS(4); ++rep_) { PHASE_BEGIN();
            if (G >= 2 * BATCH * 8 && bx >= BATCH * 8) {
                const int G2 = G - BATCH * 8, c2 = bx - BATCH * 8;
                { SchedWf S{G2, c2, (const char*)WmoT, (const char*)WpS, (char*)WfT}; pg8::EpiBf16 E;
                  pg8::gemm_phase<pg8::Gemm<1024, 256, 256>, pg8::EpiBf16, SchedWf, true>(lds + RING_OFF, C.tid, S, E); }
                { SchedKV S{G2, c2, (const char*)MEMH, (const char*)WxkvT, (char*)KVX}; pg8::EpiBf16 E;
                  pg8::gemm_phase<pg8::Gemm<DM, DM, DM>, pg8::EpiBf16, SchedKV, true>(lds + RING_OFF, C.tid, S, E); }
                sub_barrier(ctl + 16384, (unsigned)((l - a.l_lo + 1) * G2));
                { SchedQK S2{G2, c2, (const char*)KVX, (const char*)WxqP, (char*)WQK}; pg8::EpiBf16 E2;
                  pg8::gemm_phase<pg8::Gemm<4096, DM, 512>, pg8::EpiBf16, SchedQK, true>(lds + RING_OFF, C.tid, S2, E2); }
            } else {
#pragma unroll 1
                for (int bh = bx; bh < BATCH * 8; bh += G) dn_scan(C.tid, lds, QKVN, wsl + WS_REC, PBUF, AMIX, INP(9) + (size_t)l * 128, bh >> 3, bh & 7);
                if (G < 2 * BATCH * 8) {
                    { SchedWf S{G, bx, (const char*)WmoT, (const char*)WpS, (char*)WfT}; pg8::EpiBf16 E;
                      pg8::gemm_phase<pg8::Gemm<1024, 256, 256>, pg8::EpiBf16, SchedWf, true>(lds + RING_OFF, C.tid, S, E); }
                    { SchedKV S{G, bx, (const char*)MEMH, (const char*)WxkvT, (char*)KVX}; pg8::EpiBf16 E;
                      pg8::gemm_phase<pg8::Gemm<DM, DM, DM>, pg8::EpiBf16, SchedKV, true>(lds + RING_OFF, C.tid, S, E); }
                }
            }
            SEAM();
        }
        if (IN(6)) for (int rep_ = 0; rep_ < REPS(6); ++rep_) { PHASE_BEGIN();
            const bool ovfirst = ((bx >> 3) & 1) != 0;
#define PH6_MIX() do { SchedX S{G, bx, (const char*)AMIX, (const char*)WfT, (char*)XB}; pg8::EpiResid E{XB, XB, SSQ}; \
                pg8::gemm_phase<pg8::Gemm<DM, DM, DM>, pg8::EpiResid, SchedX, true>(lds + RING_OFF, C.tid, S, E); } while (0)
#define PH6_OV() do { if (G < 2 * BATCH * 8) { SchedQK S2{G, bx, (const char*)KVX, (const char*)WxqP, (char*)WQK}; pg8::EpiBf16 E2; \
                  pg8::gemm_phase<pg8::Gemm<4096, DM, 512>, pg8::EpiBf16, SchedQK, true>(lds + RING_OFF, C.tid, S2, E2); } \
                { SchedOV S3{G, bx, (const char*)WxoT, (const char*)KVX, (char*)WOV}; pg8::EpiBf16 E3; \
                  pg8::gemm_phase<pg8::Gemm<DM, 4096, 512>, pg8::EpiBf16, SchedOV, true>(lds + RING_OFF, C.tid, S3, E3); } } while (0)
            if (ovfirst) { PH6_OV(); PH6_MIX(); } else { PH6_MIX(); PH6_OV(); }
#undef PH6_MIX
#undef PH6_OV
            SEAM();
        }
        if (IN(7)) for (int rep_ = 0; rep_ < REPS(7); ++rep_) { PHASE_BEGIN(); rstd_finish(C, SSQ, RSTD, M); SEAM(); }
        if (IN(9)) for (int rep_ = 0; rep_ < REPS(9); ++rep_) { PHASE_BEGIN();
            SchedS S{G, bx, (const char*)XB, (const char*)WQK, (char*)PATT}; pg8::EpiSoftmax E{0.04419417382415922f, (LAS float*)(lds + RING_BYTES), RSTD};
            pg8::gemm_phase<pg8::Gemm<DM, DM, DM>, pg8::EpiSoftmax, SchedS, true>(lds + RING_OFF, C.tid, S, E);
            SEAM();
        }
        if (IN(12)) for (int rep_ = 0; rep_ < REPS(12); ++rep_) { PHASE_BEGIN();
            SchedXO S{G, bx, (const char*)PATT, (const char*)WOV}; pg8::EpiResid E{XB, XB, SSQ};
            pg8::gemm_phase<pg8::Gemm<1024, 1024, 1024>, pg8::EpiResid, SchedXO, true>(lds + RING_OFF, C.tid, S, E);
            SEAM();
        }
        if (IN(13)) for (int rep_ = 0; rep_ < REPS(13); ++rep_) { PHASE_BEGIN(); rstd_finish(C, SSQ, RSTD, M); SEAM(); }
        if (IN(14)) for (int rep_ = 0; rep_ < REPS(14); ++rep_) { PHASE_BEGIN();
            SchedGU S{G, bx, (const char*)XB, (const char*)WguT, (char*)GB, (char*)UB};
            pg8::EpiGLU E{INP(19) + (size_t)l * 3 * FF, INP(20) + (size_t)l * FF, GB, HALOG, FIXG, FIXU, (LAS float*)(lds + RING_BYTES), RSTD};
            pg8::gemm_phase<pg8::Gemm<DM, DM, DM>, pg8::EpiGLU, SchedGU, true>(lds + RING_OFF, C.tid, S, E);
            SEAM();
        }
        if (IN(15)) for (int rep_ = 0; rep_ < REPS(15); ++rep_) { PHASE_BEGIN();
            const float* cw = INP(19) + (size_t)l * 3 * FF; const float* cb = INP(20) + (size_t)l * FF;
            for (int i = C.gw * 64 + C.lane; i < (M / 256) * 2 * (FF / 4); i += C.NGW * 64) {
                const int c4 = (i % (FF / 4)) * 4, pr = i / (FF / 4), pm = pr >> 1, r = pr & 1;
                if ((pm & 7) == 0) continue;
                const f32x4 g0 = *(const f32x4*)(FIXG + (size_t)(pm * 2 + r) * FF + c4), up = *(const f32x4*)(FIXU + (size_t)(pm * 2 + r) * FF + c4);
                const f32x4 hl1 = *(const f32x4*)(HALOG + (size_t)((pm - 1) * 2 + 1) * FF + c4);
                const f32x4 g1 = r ? *(const f32x4*)(FIXG + (size_t)(pm * 2) * FF + c4) : hl1;
                const f32x4 g2 = r ? hl1 : *(const f32x4*)(HALOG + (size_t)((pm - 1) * 2) * FF + c4);
                const f32x4 w0 = *(const f32x4*)(cw + c4), w1 = *(const f32x4*)(cw + FF + c4), w2 = *(const f32x4*)(cw + 2 * FF + c4), bb = *(const f32x4*)(cb + c4);
                float hv[4];
#pragma unroll
                for (int j = 0; j < 4; ++j) hv[j] = silu_f(bb[j] + w2[j] * g0[j] + w1[j] * g1[j] + w0[j] * g2[j]) * (up[j] * -1.4426950408889634f);
                u32x2 o; o.x = cvt_pk_bf16(hv[0], hv[1]); o.y = cvt_pk_bf16(hv[2], hv[3]);
                *(u32x2*)(GB + (size_t)(pm * 256 + r) * FF + c4) = o;
            }
            SEAM();
        }
        if (IN(16)) for (int rep_ = 0; rep_ < REPS(16); ++rep_) { PHASE_BEGIN();
            SchedD S{G, bx, (const char*)GB, (const char*)WdT, (char*)XB}; pg8::EpiResid E{XB, XB, SSQ};
            pg8::gemm_phase<pg8::Gemm<FF, FF, FF>, pg8::EpiResid, SchedD, true>(lds + RING_OFF, C.tid, S, E);
            if (l != DEPTH - 1 || IN(17)) SEAM();
        }
        if (IN(17) && l == DEPTH - 1) { PHASE_BEGIN(); (void)wsl; (void)bx; (void)G; rmsnorm_rows_f32(C, XB, a.out + zoff, INP(22), M); }
    }
#undef SEAM
#undef IN
}

extern "C" void kernel_launch(void* const* d_in, const int* in_sizes, int n_in, void* d_out, int out_size, void* d_ws, size_t ws_size, hipStream_t stream) {
    static int grid = 0;
    if (grid == 0) {
        if (n_in != 23 || in_sizes[0] != M * DM || out_size != M * DM || ws_size < WS_END) { fprintf(stderr, "kernel_launch: unexpected shapes (n_in %d, in0 %d, out %d, ws %zu)\n", n_in, n_in > 0 ? in_sizes[0] : -1, out_size, ws_size); grid = -1; return; }
        int dev = 0, cus = 0, per_cu = 0;
        if (hipGetDevice(&dev) != hipSuccess || hipDeviceGetAttribute(&cus, hipDeviceAttributeMultiprocessorCount, dev) != hipSuccess) { grid = -1; return; }
        if (hipFuncSetAttribute((const void*)fwd_kernel, hipFuncAttributeMaxDynamicSharedMemorySize, LDS_BYTES) != hipSuccess) { fprintf(stderr, "kernel_launch: hipFuncSetAttribute failed\n"); grid = -1; return; }
        if (hipOccupancyMaxActiveBlocksPerMultiprocessor(&per_cu, (const void*)fwd_kernel, NTHR, LDS_BYTES) != hipSuccess || per_cu < 1) fprintf(stderr, "kernel_launch: occupancy query says %d\n", per_cu);
        (void)hipGetLastError();
        grid = cus;
    }
    if (grid < 0) return;
    if (hipMemsetAsync((char*)d_ws + WS_CTL, 0, CTL_ZERO_BYTES, stream) != hipSuccess) return;
    Args a{};
    for (int i = 0; i < 23; ++i) a.in[i] = (const float*)d_in[i];
    a.out = (float*)d_out; a.ws = (unsigned char*)d_ws; a.pad = 0;
#if ONE_LAUNCH
    a.l_lo = 0; a.l_hi = DEPTH; a.ph_lo = 0; a.ph_hi = NPH; a.single = 1;
    hipLaunchKernelGGL(fwd_kernel, dim3(grid), dim3(NTHR), LDS_BYTES, stream, a);
#else
    a.single = 0;
    for (int l = 0; l < DEPTH; ++l)
        for (int p = 0; p < NPH; ++p) {
            if (p == NPH - 1 && l != DEPTH - 1) continue;
            a.l_lo = l; a.l_hi = l + 1; a.ph_lo = p; a.ph_hi = p + 1;
            hipLaunchKernelGGL(fwd_kernel, dim3(grid), dim3(NTHR), LDS_BYTES, stream, a);
        }
#endif
}
```

```cpp
#include <hip/hip_runtime.h>
#include <cstdio>
#include <cstdint>

#ifndef ONE_LAUNCH
#define ONE_LAUNCH 1
#endif

#define LAS __attribute__((address_space(3)))
#define GAS __attribute__((address_space(1)))
typedef unsigned short bf16_t;
typedef short bf16x8 __attribute__((ext_vector_type(8)));
typedef float f32x4 __attribute__((ext_vector_type(4)));
typedef float f32x2 __attribute__((ext_vector_type(2)));
typedef unsigned u32x4 __attribute__((ext_vector_type(4)));
typedef unsigned u32x2 __attribute__((ext_vector_type(2)));

constexpr int DM = 2048, BATCH = 16, SEQ = 2048, DEPTH = 4, MEM_LEN = 256;
constexpr int M = BATCH * SEQ;
constexpr int MM = BATCH * MEM_LEN;
constexpr int INW = 5136, INW_PAD = 5376, PW = 5120;
constexpr int FF = 5632;
constexpr int NWAVES = 8, NTHR = 512;
constexpr float EPS = 1e-6f;

constexpr size_t MiB = 1u << 20;
constexpr size_t WS_CTL = 0, CTL_ZERO_BYTES = 1 * MiB;
constexpr size_t WS_MEMH = 2 * MiB, WS_KX = 18 * MiB, WS_VT = 34 * MiB;
constexpr size_t WS_WIN = 50 * MiB, WS_WF = 71 * MiB, WS_WMOT = 79 * MiB, WS_WPS = 83 * MiB, WS_WXQ = 84 * MiB, WS_WXKV = 92 * MiB, WS_WXO = 108 * MiB, WS_WGU = 116 * MiB, WS_WD = 160 * MiB;
constexpr size_t WS_LOGIT = 182 * MiB, WS_BETA = 184 * MiB, WS_GDEC = 185 * MiB;
constexpr size_t WS_H = 192 * MiB;
constexpr size_t WS_PBUF = 320 * MiB, WS_QKVN = 640 * MiB, WS_ODN = 832 * MiB;
constexpr size_t WS_WQK = 1188 * MiB, WS_WOV = 512 * MiB, WS_PATT = 576 * MiB;
constexpr size_t WS_G = 320 * MiB, WS_U = 672 * MiB;
constexpr size_t WS_HALO = 680 * MiB, WS_FIXG = 688 * MiB, WS_FIXU = 696 * MiB;
constexpr size_t WS_SSQ = 960 * MiB, WS_RSTD = 964 * MiB;
constexpr size_t WS_REC = 1024 * MiB;
constexpr size_t REC_BYTES = 41984, REC_NW = 0, REC_U = 16384, REC_AT = 32768, REC_MISC = 40960;
constexpr size_t WS_END = 1252 * MiB;
constexpr int CW_BAR = 4096;

typedef __bf16 bf16x2_t __attribute__((ext_vector_type(2)));
__device__ __forceinline__ unsigned cvt_pk_bf16_c(float lo, float hi) { const f32x2 v = {lo, hi}; return __builtin_bit_cast(unsigned, __builtin_convertvector(v, bf16x2_t)); }
__device__ __forceinline__ unsigned cvt_pk_bf16(float lo, float hi) { unsigned r; asm("v_cvt_pk_bf16_f32 %0, %1, %2" : "=v"(r) : "v"(lo), "v"(hi)); return r; }
__device__ __forceinline__ float bflo(unsigned u) { return __uint_as_float(u << 16); }
__device__ __forceinline__ float bfhi(unsigned u) { return __uint_as_float(u & 0xffff0000u); }
template <int X> __device__ __forceinline__ float sx(float v) { return __builtin_bit_cast(float, __builtin_amdgcn_ds_swizzle(__builtin_bit_cast(int, v), (X << 10) | 0x1f)); }
__device__ __forceinline__ float wave_sum(float v) {
    v += sx<1>(v); v += sx<2>(v); v += sx<4>(v); v += sx<8>(v); v += sx<16>(v);
    return __builtin_bit_cast(float, __builtin_amdgcn_readlane(__builtin_bit_cast(int, v), 0)) + __builtin_bit_cast(float, __builtin_amdgcn_readlane(__builtin_bit_cast(int, v), 32));
}
__device__ __forceinline__ float silu_f(float y) { return y * __builtin_amdgcn_rcpf(1.0f + __expf(-y)); }
#define LDS_WAIT() asm volatile("s_waitcnt lgkmcnt(0)" ::: "memory")

namespace pg8 {
constexpr int BM = 256, BK = 64, HALF = 128, HTB = HALF * BK * 2, STAGE_BYTES = 8 * HTB, NXCD = 8, WGM = 4;
__host__ __device__ __forceinline__ int lds_byte(int r, int c) { const int st = (r >> 4) * 2 + (c >> 5), rr = r & 15, cc = c & 31, ob = rr * 64 + cc * 2; return st * 1024 + (ob ^ (((ob >> 9) & 1) << 5)); }
__host__ __device__ __forceinline__ void stage_rc(int b, int& R, int& C) { const int st = b / 1024, sb = b % 1024, swz = sb ^ (((sb >> 9) & 1) << 5); R = (st >> 1) * 16 + swz / 64; C = (st & 1) * 32 + (swz % 64) / 2; }
__host__ __device__ __forceinline__ int perm32(int rho) { const int n = rho >> 4, i = rho & 15; return 8 * (i >> 2) + 4 * n + (i & 3); }

struct Unit { int pm, pn; };
template <int LDA, int LDB, int KK> struct Gemm { static constexpr int lda = LDA, ldb = LDB, K = KK; };

__device__ __forceinline__ bool tile_of(int i, int G, int c, int nM, int nN, int& pm, int& pn) {
    const int nwg = nM * nN; const long L = (long)i * G + c; if (L >= nwg) return false;
    int wgid = (int)L; { const int q = nwg / NXCD, r = nwg % NXCD, xcd = wgid % NXCD, off = wgid / NXCD; wgid = (xcd < r ? xcd * (q + 1) : r * (q + 1) + (xcd - r) * q) + off; }
    const int nig = WGM * nN, gid = wgid / nig, fm = gid * WGM, gsz = (nM - fm) < WGM ? (nM - fm) : WGM;
    pm = fm + ((wgid % nig) % gsz); pn = (wgid % nig) / gsz; return true;
}

struct NoPre {};
struct RsPre { float r[2][4]; };
__device__ __forceinline__ RsPre load_rstd(const float* rstd, const Unit& u, int wr, int fr) { RsPre p;
#pragma unroll
    for (int ai = 0; ai < 2; ++ai)
#pragma unroll
        for (int m = 0; m < 4; ++m) p.r[ai][m] = ((const GAS float*)rstd)[u.pm * BM + wr * 64 + fr + ai * HALF + m * 16];
    return p; }
struct EpiBf16 {
    static constexpr bool PERM = true;
    __device__ __forceinline__ NoPre pre(const Unit& u, int wr, int fr) const { (void)u; (void)wr; (void)fr; return NoPre{}; }
    __device__ __forceinline__ int tail(const Unit&) const { return 16; }
    template <class Sched> __device__ __forceinline__ void operator()(const f32x4 (&acc)[2][2][4][2], const Unit& u, const Sched& S, int wr, int wc, int fr, int fq, const NoPre& pre) const {
        const int ldc = S.ldc(u);
        GAS bf16_t* base = (GAS bf16_t*)S.optr(u) + (size_t)(wr * 64 + fr) * ldc + wc * 32 + 8 * fq;
#pragma unroll
        for (int ai = 0; ai < 2; ++ai)
#pragma unroll
            for (int m = 0; m < 4; ++m) { GAS bf16_t* rowp = base + (size_t)(ai * HALF + m * 16) * ldc;
#pragma unroll
                for (int bj = 0; bj < 2; ++bj) { const f32x4 v0 = acc[ai][bj][m][0], v1 = acc[ai][bj][m][1];
                    u32x4 w; w.x = cvt_pk_bf16(v0[0], v0[1]); w.y = cvt_pk_bf16(v0[2], v0[3]); w.z = cvt_pk_bf16(v1[0], v1[1]); w.w = cvt_pk_bf16(v1[2], v1[3]);
                    *(GAS u32x4*)(rowp + bj * HALF) = w; } }
    }
};
struct EpiP {
    static constexpr bool PERM = true;
    float* logit; const float* rstd;
    __device__ __forceinline__ RsPre pre(const Unit& u, int wr, int fr) const { return load_rstd(rstd, u, wr, fr); }
    __device__ __forceinline__ int tail(const Unit& u) const { (void)u; return 16; }
    template <class Sched> __device__ __forceinline__ void operator()(const f32x4 (&acc)[2][2][4][2], const Unit& u, const Sched& S, int wr, int wc, int fr, int fq, const RsPre& pre) const {
        const float (&rs)[2][4] = pre.r;
        {
            const int ldc = S.ldc(u);
            GAS bf16_t* base = (GAS bf16_t*)S.optr(u) + (size_t)(wr * 64 + fr) * ldc + wc * 32 + 8 * fq;
#pragma unroll
            for (int ai = 0; ai < 2; ++ai)
#pragma unroll
                for (int m = 0; m < 4; ++m) { GAS bf16_t* rowp = base + (size_t)(ai * HALF + m * 16) * ldc; const float r = rs[ai][m];
#pragma unroll
                    for (int bj = 0; bj < 2; ++bj) { const f32x4 v0 = acc[ai][bj][m][0] * r, v1 = acc[ai][bj][m][1] * r;
                        u32x4 w; w.x = cvt_pk_bf16(v0[0], v0[1]); w.y = cvt_pk_bf16(v0[2], v0[3]); w.z = cvt_pk_bf16(v1[0], v1[1]); w.w = cvt_pk_bf16(v1[2], v1[3]);
                        *(GAS u32x4*)(rowp + bj * HALF) = w; } }
        }
    }
};
struct EpiResid {
    static constexpr bool PERM = true;
    const bf16_t* base; bf16_t* out; float* ssq;
    __device__ __forceinline__ NoPre pre(const Unit& u, int wr, int fr) const { (void)u; (void)wr; (void)fr; return NoPre{}; }
    __device__ __forceinline__ int tail(const Unit&) const { return 16; }
    template <class Sched> __device__ __forceinline__ void operator()(const f32x4 (&acc)[2][2][4][2], const Unit& u, const Sched&, int wr, int wc, int fr, int fq, const NoPre& pre) const {
        const size_t off0 = (size_t)(u.pm * BM + wr * 64 + fr) * DM + u.pn * BM + wc * 32 + 8 * fq;
        const int lane = fq * 16 + fr;
        u32x4 bs[2][4][2];
#pragma unroll
        for (int ai = 0; ai < 2; ++ai)
#pragma unroll
            for (int m = 0; m < 4; ++m)
#pragma unroll
                for (int bj = 0; bj < 2; ++bj) bs[ai][m][bj] = *(const GAS u32x4*)((const GAS bf16_t*)base + off0 + (size_t)(ai * HALF + m * 16) * DM + bj * HALF);
        GAS float* sp = (GAS float*)ssq + (size_t)(u.pm * BM + wr * 64 + fr) * 32 + u.pn * 4 + wc;
#pragma unroll
        for (int ai = 0; ai < 2; ++ai)
#pragma unroll
            for (int m = 0; m < 4; ++m) { float sq = 0.f;
#pragma unroll
                for (int bj = 0; bj < 2; ++bj) { const u32x4 b = bs[ai][m][bj]; const f32x4 v0 = acc[ai][bj][m][0], v1 = acc[ai][bj][m][1];
                    const float x0 = bflo(b.x) + v0[0], x1 = bfhi(b.x) + v0[1], x2 = bflo(b.y) + v0[2], x3 = bfhi(b.y) + v0[3], x4 = bflo(b.z) + v1[0], x5 = bfhi(b.z) + v1[1], x6 = bflo(b.w) + v1[2], x7 = bfhi(b.w) + v1[3];
                    sq += ((x0 * x0 + x1 * x1) + (x2 * x2 + x3 * x3)) + ((x4 * x4 + x5 * x5) + (x6 * x6 + x7 * x7));
                    u32x4 w; w.x = cvt_pk_bf16(x0, x1); w.y = cvt_pk_bf16(x2, x3); w.z = cvt_pk_bf16(x4, x5); w.w = cvt_pk_bf16(x6, x7);
                    *(GAS u32x4*)((GAS bf16_t*)out + off0 + (size_t)(ai * HALF + m * 16) * DM + bj * HALF) = w; }
                sq += sx<16>(sq); sq += __builtin_bit_cast(float, __builtin_amdgcn_ds_bpermute((lane ^ 32) << 2, __builtin_bit_cast(int, sq)));
                if (fq == 0) sp[(size_t)(ai * HALF + m * 16) * 32] = sq; }
    }
};
template <int N> __device__ __forceinline__ float dpp_shr(float old, float x) { return __builtin_bit_cast(float, __builtin_amdgcn_update_dpp(__builtin_bit_cast(int, old), __builtin_bit_cast(int, x), 0x110 + N, 0xf, 0xf, false)); }
template <int N> __device__ __forceinline__ float dpp_ror(float x) { return __builtin_bit_cast(float, __builtin_amdgcn_update_dpp(0, __builtin_bit_cast(int, x), 0x120 + N, 0xf, 0xf, false)); }
struct EpiGLU {
    static constexpr bool PERM = true;
    const float* cw; const float* cb; bf16_t* hf; float* halo_g; float* fix_g; float* fix_u; LAS float* ex; const float* rstd;
    __device__ __forceinline__ RsPre pre(const Unit& u, int wr, int fr) const { return load_rstd(rstd, u, wr, fr); }
    __device__ __forceinline__ int tail(const Unit&) const { return 8; }
    template <class Sched> __device__ __forceinline__ void operator()(const f32x4 (&acc_)[2][2][4][2], const Unit& u, const Sched&, int wr, int wc, int fr, int fq, const RsPre& pre) const {
        f32x4 (&acc)[2][2][4][2] = const_cast<f32x4 (&)[2][2][4][2]>(acc_);
#pragma unroll
        for (int ai = 0; ai < 2; ++ai)
#pragma unroll
            for (int m = 0; m < 4; ++m) { const float r = pre.r[ai][m], ru = r * -0.6931471805599453f;
#pragma unroll
                for (int n = 0; n < 2; ++n) { acc[ai][0][m][n] = acc[ai][0][m][n] * r; acc[ai][1][m][n] = acc[ai][1][m][n] * ru; } }
        const int col0 = wc * 32 + 8 * fq, gcol = u.pn * 128 + col0;
        if (fr >= 14) {
#pragma unroll
            for (int ai = 0; ai < 2; ++ai)
#pragma unroll
                for (int n = 0; n < 2; ++n) *(LAS f32x4*)(ex + ((ai * 2 + wr) * 2 + (fr - 14)) * 128 + col0 + 4 * n) = acc[ai][0][3][n];
            if (wr == 1) {
#pragma unroll
                for (int n = 0; n < 2; ++n) *(GAS f32x4*)((GAS float*)halo_g + (size_t)(u.pm * 2 + (fr - 14)) * FF + gcol + 4 * n) = acc[1][0][3][n]; }
        }
        if (wr == 0 && fr < 2) {
#pragma unroll
            for (int n = 0; n < 2; ++n) { *(GAS f32x4*)((GAS float*)fix_g + (size_t)(u.pm * 2 + fr) * FF + gcol + 4 * n) = acc[0][0][0][n]; *(GAS f32x4*)((GAS float*)fix_u + (size_t)(u.pm * 2 + fr) * FF + gcol + 4 * n) = acc[0][1][0][n]; } }
        f32x4 w0[2], w1[2], w2[2], bb[2];
#pragma unroll
        for (int n = 0; n < 2; ++n) { const GAS float* cwg = (const GAS float*)cw; w0[n] = *(const GAS f32x4*)(cwg + gcol + 4 * n); w1[n] = *(const GAS f32x4*)(cwg + FF + gcol + 4 * n); w2[n] = *(const GAS f32x4*)(cwg + 2 * FF + gcol + 4 * n); bb[n] = *(const GAS f32x4*)((const GAS float*)cb + gcol + 4 * n);
            w0[n] = w0[n] * -1.4426950408889634f; w1[n] = w1[n] * -1.4426950408889634f; w2[n] = w2[n] * -1.4426950408889634f; bb[n] = bb[n] * -1.4426950408889634f; }
        asm volatile("s_waitcnt lgkmcnt(0)" ::: "memory"); __builtin_amdgcn_s_barrier(); asm volatile("" ::: "memory");
        GAS bf16_t* hb = (GAS bf16_t*)hf + (size_t)(u.pm * BM + wr * 64 + fr) * FF + gcol;
#pragma unroll
        for (int ai = 0; ai < 2; ++ai) {
            f32x4 yp[2];
            if (ai == 0 && wr == 0) { yp[0] = (f32x4){0.f, 0.f, 0.f, 0.f}; yp[1] = yp[0]; }
            else { const int pb = wr == 1 ? ai * 2 : (ai - 1) * 2 + 1; const LAS float* e = ex + (pb * 2 + (fr >= 14 ? fr - 14 : 0)) * 128 + col0;
                yp[0] = *(const LAS f32x4*)e; yp[1] = *(const LAS f32x4*)(e + 4); }
#pragma unroll
            for (int m = 0; m < 4; ++m) {
                u32x4 ow;
#pragma unroll
                for (int n = 0; n < 2; ++n) { const f32x4 g0 = acc[ai][0][m][n], up = acc[ai][1][m][n]; float hv[4];
#pragma unroll
                    for (int j = 0; j < 4; ++j) { const float g1 = dpp_shr<1>(dpp_ror<1>(yp[n][j]), g0[j]), g2 = dpp_shr<2>(dpp_ror<2>(yp[n][j]), g0[j]);
                        const float y = bb[n][j] + w2[n][j] * g0[j] + w1[n][j] * g1 + w0[n][j] * g2; hv[j] = (y * __builtin_amdgcn_rcpf(1.0f + __builtin_amdgcn_exp2f(y))) * up[j]; }
                    if (n == 0) { ow.x = cvt_pk_bf16(hv[0], hv[1]); ow.y = cvt_pk_bf16(hv[2], hv[3]); } else { ow.z = cvt_pk_bf16(hv[0], hv[1]); ow.w = cvt_pk_bf16(hv[2], hv[3]); }
                    yp[n] = g0; }
                *(GAS u32x4*)(hb + (size_t)(ai * HALF + m * 16) * FF) = ow;
            }
        }
    }
};

struct EpiSoftmax {
    static constexpr bool PERM = true;
    float scale; LAS float* red; const float* rstd;
    __device__ __forceinline__ RsPre pre(const Unit& u, int wr, int fr) const { return load_rstd(rstd, u, wr, fr); }
    __device__ __forceinline__ int tail(const Unit&) const { return 16; }
    template <class Sched> __device__ __forceinline__ void operator()(const f32x4 (&acc_)[2][2][4][2], const Unit& u, const Sched& S, int wr, int wc, int fr, int fq, const RsPre& pre) const {
        f32x4 (&acc)[2][2][4][2] = const_cast<f32x4 (&)[2][2][4][2]>(acc_);
        const int lane = fq * 16 + fr; float mw[2][4];
#pragma unroll
        for (int ai = 0; ai < 2; ++ai)
#pragma unroll
            for (int m = 0; m < 4; ++m) {
                float mx = -3.0e38f; const float rsc = scale * pre.r[ai][m];
#pragma unroll
                for (int bj = 0; bj < 2; ++bj)
#pragma unroll
                    for (int n = 0; n < 2; ++n) { const f32x4 v = acc[ai][bj][m][n] * rsc; acc[ai][bj][m][n] = v; mx = fmaxf(mx, fmaxf(fmaxf(v[0], v[1]), fmaxf(v[2], v[3]))); }
                mx = fmaxf(mx, sx<16>(mx)); mx = fmaxf(mx, __builtin_bit_cast(float, __builtin_amdgcn_ds_bpermute((lane ^ 32) << 2, __builtin_bit_cast(int, mx))));
                float sm = 0.f;
#pragma unroll
                for (int bj = 0; bj < 2; ++bj)
#pragma unroll
                    for (int n = 0; n < 2; ++n) { f32x4 v = acc[ai][bj][m][n]; v[0] = __expf(v[0] - mx); v[1] = __expf(v[1] - mx); v[2] = __expf(v[2] - mx); v[3] = __expf(v[3] - mx); acc[ai][bj][m][n] = v; sm += (v[0] + v[1]) + (v[2] + v[3]); }
                sm += sx<16>(sm); sm += __builtin_bit_cast(float, __builtin_amdgcn_ds_bpermute((lane ^ 32) << 2, __builtin_bit_cast(int, sm)));
                mw[ai][m] = mx;
                if (fq == 0) *(LAS f32x2*)(red + ((ai * HALF + wr * 64 + m * 16 + fr) * 4 + wc) * 2) = (f32x2){mx, sm};
            }
        asm volatile("s_waitcnt lgkmcnt(0)" ::: "memory"); __builtin_amdgcn_s_barrier(); asm volatile("" ::: "memory");
        const int ldc = S.ldc(u);
        GAS bf16_t* base = (GAS bf16_t*)S.optr(u) + (size_t)(wr * 64 + fr) * ldc + wc * 32 + 8 * fq;
#pragma unroll
        for (int ai = 0; ai < 2; ++ai)
#pragma unroll
            for (int m = 0; m < 4; ++m) {
                const LAS f32x4* rp = (const LAS f32x4*)(red + (ai * HALF + wr * 64 + m * 16 + fr) * 8); const f32x4 p0 = rp[0], p1 = rp[1];
                const float M4 = fmaxf(fmaxf(p0[0], p0[2]), fmaxf(p1[0], p1[2]));
                const float tot = (p0[1] * __expf(p0[0] - M4) + p0[3] * __expf(p0[2] - M4)) + (p1[1] * __expf(p1[0] - M4) + p1[3] * __expf(p1[2] - M4));
                const float f = __expf(mw[ai][m] - M4) * __builtin_amdgcn_rcpf(tot);
                GAS bf16_t* rowp = base + (size_t)(ai * HALF + m * 16) * ldc;
#pragma unroll
                for (int bj = 0; bj < 2; ++bj) { const f32x4 v0 = acc[ai][bj][m][0] * f, v1 = acc[ai][bj][m][1] * f;
                    u32x4 w; w.x = cvt_pk_bf16(v0[0], v0[1]); w.y = cvt_pk_bf16(v0[2], v0[3]); w.z = cvt_pk_bf16(v1[0], v1[1]); w.w = cvt_pk_bf16(v1[2], v1[3]);
                    *(GAS u32x4*)(rowp + bj * HALF) = w; }
            }
    }
};

struct EpiF32Scale {
    static constexpr bool PERM = false;
    float scale;
    __device__ __forceinline__ int tail(const Unit&) const { return 0; }
    template <class Sched> __device__ __forceinline__ void operator()(const f32x4 (&acc)[2][2][4][2], const Unit& u, const Sched& S, int wr, int wc, int fr, int fq) const {
        const int ldc = S.ldc(u);
        float* base = (float*)S.optr(u) + (size_t)(wr * 64 + fr) * ldc + wc * 32 + 4 * fq;
#pragma unroll
        for (int ai = 0; ai < 2; ++ai)
#pragma unroll
            for (int m = 0; m < 4; ++m) { float* rowp = base + (size_t)(ai * HALF + m * 16) * ldc;
#pragma unroll
                for (int bj = 0; bj < 2; ++bj)
#pragma unroll
                    for (int n = 0; n < 2; ++n) *(f32x4*)(rowp + bj * HALF + n * 16) = acc[ai][bj][m][n] * scale; }
    }
};

template <class G_, class Epi, class Sched, bool ALIGN_EPI>
__device__ __forceinline__ void gemm_phase(LAS unsigned char* lds, const int tid, const Sched& S, const Epi& E) {
    constexpr G_ g{};
    const int wid = __builtin_amdgcn_readfirstlane(tid >> 6), lane = tid & 63, wr = wid >> 2, wc = wid & 3, fr = lane & 15, fq = lane >> 4;
    constexpr int K = g.K, nt = K / BK;
    unsigned voffA[2], voffB[2];
#pragma unroll
    for (int i = 0; i < 2; ++i) { int R, C; stage_rc(tid * 16 + i * 8192, R, C); const int Rb = Epi::PERM ? ((R & ~31) + perm32(R & 31)) : R;
        voffA[i] = (unsigned)(R * g.lda + C) * 2u; voffB[i] = (unsigned)(Rb * g.ldb + C) * 2u; }
    const size_t kstep = (size_t)(BK * 2);
    const size_t hstepA = (size_t)HALF * g.lda * 2, hstepB = (size_t)HALF * g.ldb * 2;
    const unsigned ldsw = (unsigned)wid * 1024u;
    const int aoff = lds_byte(wr * 64 + fr, fq * 8), boff = lds_byte(wc * 32 + fr, fq * 8);
#define PG8_SA(b, h) (((b) * 2 + (h)) * HTB)
#define PG8_SB(b, h) ((4 + (b) * 2 + (h)) * HTB)
#define PG8_STAGE(bufoff, gbase, voff) do { _Pragma("unroll") for (int _i = 0; _i < 2; ++_i) \
        __builtin_amdgcn_global_load_lds((const unsigned*)((const char*)(gbase) + (voff)[_i]), (LAS unsigned*)(lds + (bufoff) + ldsw + _i * 8192), 16, 0, 0); } while (0)
#define PG8_LDA(dst, b, h) do { _Pragma("unroll") for (int m = 0; m < 4; ++m) _Pragma("unroll") for (int k = 0; k < 2; ++k) dst[m][k] = *(const LAS bf16x8*)(lds + PG8_SA(b, h) + aoff + m * 2048 + k * 1024); } while (0)
#define PG8_LDB(dst, b, h) do { _Pragma("unroll") for (int n = 0; n < 2; ++n) _Pragma("unroll") for (int k = 0; k < 2; ++k) dst[n][k] = *(const LAS bf16x8*)(lds + PG8_SB(b, h) + boff + n * 2048 + k * 1024); } while (0)
#define PG8_MMA(ai, bj, At, Bt) do { __builtin_amdgcn_s_setprio(1); _Pragma("unroll") for (int m = 0; m < 4; ++m) _Pragma("unroll") for (int n = 0; n < 2; ++n) _Pragma("unroll") for (int k = 0; k < 2; ++k) \
        acc[ai][bj][m][n] = __builtin_amdgcn_mfma_f32_16x16x32_bf16(Bt[n][k], At[m][k], acc[ai][bj][m][n], 0, 0, 0); __builtin_amdgcn_s_setprio(0); } while (0)
#define PG8_WAIT_V(n) asm volatile("s_waitcnt vmcnt(" #n ")" ::: "memory")
#define PG8_WAIT_L(n) asm volatile("s_waitcnt lgkmcnt(" #n ")" ::: "memory")
#define PG8_WAIT_VR(tl) do { if ((tl) == 0) PG8_WAIT_V(8); else if ((tl) == 16) PG8_WAIT_V(24); else if ((tl) == 8) PG8_WAIT_V(16); else PG8_WAIT_V(12); } while (0)
#define PG8_BAR __builtin_amdgcn_s_barrier()
#define PG8_SCHED __builtin_amdgcn_sched_barrier(0)
    Unit cur, nxt; int ui = 0, ptail = 0;
    if (!S.next(0, cur)) return;
    f32x4 acc[2][2][4][2];
#pragma unroll
    for (int a = 0; a < 2; ++a)
#pragma unroll
        for (int b = 0; b < 2; ++b)
#pragma unroll
            for (int m = 0; m < 4; ++m)
#pragma unroll
                for (int n = 0; n < 2; ++n) acc[a][b][m][n] = (f32x4){0.f, 0.f, 0.f, 0.f};
    bf16x8 At[4][2], B0[2][2], B1[2][2];
    const char* cA = S.aptr(cur); const char* cB = S.bptr(cur);
    PG8_STAGE(PG8_SB(0, 0), cB, voffB); PG8_STAGE(PG8_SB(0, 1), cB + hstepB, voffB); PG8_STAGE(PG8_SA(0, 0), cA, voffA); PG8_STAGE(PG8_SA(0, 1), cA + hstepA, voffA);
    if (wr == 1) PG8_BAR;
    PG8_WAIT_V(2); PG8_BAR;
    PG8_STAGE(PG8_SB(1, 0), cB + kstep, voffB); PG8_STAGE(PG8_SA(1, 0), cA + kstep, voffA); PG8_STAGE(PG8_SB(1, 1), cB + hstepB + kstep, voffB);
    PG8_WAIT_V(6); PG8_BAR;
    for (;;) {
        const bool has_next = S.next(ui + 1, nxt);
        const char* nA = has_next ? S.aptr(nxt) : cA; const char* nB = has_next ? S.bptr(nxt) : cB;
        const auto pre = E.pre(cur, wr, fr);
#pragma unroll 1
        for (int t = 0; t < nt; t += 2) {
            const bool last = (t == nt - 2);
            const char* a1 = cA + (size_t)(t + 1) * kstep;
            const char* a2 = last ? nA : cA + (size_t)(t + 2) * kstep; const char* b2 = last ? nB : cB + (size_t)(t + 2) * kstep;
            const char* a3 = a2 + kstep; const char* b3 = b2 + kstep;
            const int rtail = (t == 0) ? ptail : 0;
            PG8_LDB(B0, 0, 0); PG8_LDB(B1, 0, 1); PG8_SCHED; PG8_LDA(At, 0, 0); PG8_STAGE(PG8_SA(1, 1), a1 + hstepA, voffA);
            PG8_WAIT_VR(rtail); PG8_WAIT_L(0); PG8_BAR; PG8_MMA(0, 0, At, B0); PG8_MMA(0, 1, At, B1); PG8_BAR; PG8_SCHED;
            PG8_LDA(At, 0, 1); PG8_STAGE(PG8_SB(0, 0), b2, voffB); PG8_STAGE(PG8_SB(0, 1), b2 + hstepB, voffB); PG8_STAGE(PG8_SA(0, 0), a2, voffA);
            PG8_WAIT_VR(rtail); PG8_WAIT_L(0); PG8_BAR; PG8_MMA(1, 0, At, B0); PG8_MMA(1, 1, At, B1); PG8_BAR; PG8_SCHED;
            PG8_LDB(B0, 1, 0); PG8_LDB(B1, 1, 1); PG8_SCHED; PG8_LDA(At, 1, 0); PG8_STAGE(PG8_SA(0, 1), a2 + hstepA, voffA);
            PG8_WAIT_V(8); PG8_WAIT_L(0); PG8_BAR; PG8_MMA(0, 0, At, B0); PG8_MMA(0, 1, At, B1); PG8_BAR; PG8_SCHED;
            PG8_LDA(At, 1, 1); PG8_STAGE(PG8_SB(1, 0), b3, voffB); PG8_STAGE(PG8_SB(1, 1), b3 + hstepB, voffB); PG8_STAGE(PG8_SA(1, 0), a3, voffA);
            PG8_WAIT_V(8); PG8_WAIT_L(0); PG8_BAR; PG8_MMA(1, 0, At, B0); PG8_MMA(1, 1, At, B1); PG8_BAR; PG8_SCHED;
        }
        if constexpr (ALIGN_EPI) { if (wr == 0) PG8_BAR; }
        E(acc, cur, S, wr, wc, fr, fq, pre);
        ptail = E.tail(cur);
        if (!has_next) break;
#pragma unroll
        for (int a = 0; a < 2; ++a)
#pragma unroll
            for (int b = 0; b < 2; ++b)
#pragma unroll
                for (int m = 0; m < 4; ++m)
#pragma unroll
                    for (int n = 0; n < 2; ++n) acc[a][b][m][n] = (f32x4){0.f, 0.f, 0.f, 0.f};
        cur = nxt; cA = nA; cB = nB; ++ui;
        if constexpr (ALIGN_EPI) { if (wr == 1) PG8_BAR; }
    }
    PG8_WAIT_V(0);
    if constexpr (!ALIGN_EPI) { if (wr == 0) PG8_BAR; }
    PG8_BAR;
#undef PG8_SA
#undef PG8_SB
#undef PG8_STAGE
#undef PG8_LDA
#undef PG8_LDB
#undef PG8_MMA
#undef PG8_WAIT_V
#undef PG8_WAIT_L
#undef PG8_WAIT_VR
#undef PG8_BAR
#undef PG8_SCHED
}
}

#define XB_TMO      128
#define XB_XCNT(j)  (256  + 64 * (j))
#define XB_XSUB(j)  (1280 + 64 * (j))
#define XB_XGEN(j)  (2304 + 64 * (j))
#define XB_TOP      3328
#define XB_TOPGEN   3392
#define XCD_BAR_WORDS 3456
#define XB_SPIN_CAP (1u << 18)
__device__ __forceinline__ unsigned xb_ld(unsigned* p)              { return __hip_atomic_load(p, __ATOMIC_RELAXED, __HIP_MEMORY_SCOPE_AGENT); }
__device__ __forceinline__ unsigned xb_add(unsigned* p, unsigned v) { return __hip_atomic_fetch_add(p, v, __ATOMIC_RELAXED, __HIP_MEMORY_SCOPE_AGENT); }
__device__ __forceinline__ unsigned xb_xcc_id() { return (unsigned)__builtin_amdgcn_s_getreg((3 << 11) | 20) & 0xFu; }
#define XB_SPIN(cond, bar) do { unsigned _sp = 0; while (cond) { __builtin_amdgcn_s_sleep(1); \
    if ((++_sp & 255u) == 0u) { if (xb_ld(&(bar)[XB_TMO])) break; if (_sp > XB_SPIN_CAP) { atomicAdd(&(bar)[XB_TMO], 1u); break; } } } } while (0)
struct XcdBarrier { unsigned* bar; unsigned x; volatile LAS unsigned* st; };
__device__ __forceinline__ XcdBarrier xcd_barrier_post(unsigned* bar, volatile LAS unsigned* st) {
    XcdBarrier b; b.bar = bar; b.x = xb_xcc_id(); b.st = st;
    if (threadIdx.x == 0) (void)xb_add(&bar[XB_XCNT(b.x)], 1u);
    return b;
}
__device__ __forceinline__ void xcd_barrier_complete(unsigned* bar, unsigned x, unsigned& nloc, unsigned& nx) {
    const unsigned G = gridDim.x * gridDim.y * gridDim.z;
    unsigned sum, cnt, mine, sp = 0u;
    for (;;) {
        sum = 0u; cnt = 0u; mine = 0u;
#pragma unroll
        for (unsigned j = 0; j < 16; ++j) { const unsigned c = xb_ld(&bar[XB_XCNT(j)]); sum += c; cnt += (c > 0u) ? 1u : 0u; mine = (j == x) ? c : mine; }
        if (sum == G) break;
        __builtin_amdgcn_s_sleep(1);
        if ((++sp & 255u) == 0u) { if (xb_ld(&bar[XB_TMO])) break; if (sp > XB_SPIN_CAP) { atomicAdd(&bar[XB_TMO], 1u); break; } }
    }
    nloc = mine > 0u ? mine : 1u; nx = cnt > 0u ? cnt : 1u;
}
__device__ __forceinline__ void xcd_barrier(const XcdBarrier& b) {
    asm volatile("s_waitcnt vmcnt(0)" ::: "memory");
    __syncthreads();
    if (threadIdx.x == 0) {
        unsigned* bar = b.bar;
        __builtin_amdgcn_s_waitcnt(0);
        unsigned nloc = b.st[0], nx = b.st[1];
        if (nloc == 0u) { xcd_barrier_complete(bar, b.x, nloc, nx); b.st[0] = nloc; b.st[1] = nx; }
        const unsigned old = xb_add(&bar[XB_XSUB(b.x)], 1u);
        const unsigned gen = old / nloc;
        if (old + 1u == (gen + 1u) * nloc) {
            __builtin_amdgcn_fence(__ATOMIC_RELEASE, "agent");
            asm volatile("s_waitcnt vmcnt(0)" ::: "memory");
            const unsigned og = xb_add(&bar[XB_TOP], 1u);
            const unsigned tg = og / nx;
            if (og + 1u == (tg + 1u) * nx) xb_add(&bar[XB_TOPGEN], 1u);
            else XB_SPIN(xb_ld(&bar[XB_TOPGEN]) == tg, bar);
            __builtin_amdgcn_fence(__ATOMIC_ACQUIRE, "agent");
            xb_add(&bar[XB_XGEN(b.x)], 1u);
            asm volatile("s_waitcnt vmcnt(0)" ::: "memory");
        } else {
            XB_SPIN(xb_ld(&bar[XB_XGEN(b.x)]) == gen, bar);
            __builtin_amdgcn_fence(__ATOMIC_ACQUIRE, "agent");
            asm volatile("s_waitcnt vmcnt(0)" ::: "memory");
        }
    }
    __syncthreads();
}

__device__ __forceinline__ void sub_barrier(unsigned* cnt, unsigned target) {
    asm volatile("s_waitcnt vmcnt(0)" ::: "memory");
    __syncthreads();
    if (threadIdx.x == 0) {
        __builtin_amdgcn_fence(__ATOMIC_RELEASE, "agent");
        asm volatile("s_waitcnt vmcnt(0)" ::: "memory");
        (void)xb_add(cnt, 1u);
        unsigned sp = 0u;
        while (xb_ld(cnt) < target) { __builtin_amdgcn_s_sleep(2); if (++sp > XB_SPIN_CAP) break; }
        __builtin_amdgcn_fence(__ATOMIC_ACQUIRE, "agent");
        asm volatile("s_waitcnt vmcnt(0)" ::: "memory");
    }
    __syncthreads();
}

constexpr int RING_OFF = 0, RING_BYTES = 131072;
constexpr int LDSCTL_OFF = 143360, MISC_OFF = LDSCTL_OFF + 320;
constexpr int LDS_BYTES = 147456;

using pg8::Unit;
template <int NM, int NN, int LDC, int OSZ, size_t ASTEP, size_t BSTEP>
struct SchedStd {
    int G, c; const char* A; const char* B; char* O;
    __device__ __forceinline__ bool next(int i, Unit& u) const { return pg8::tile_of(i, G, c, NM, NN, u.pm, u.pn); }
    __device__ __forceinline__ const char* aptr(const Unit& u) const { return A + (size_t)u.pm * ASTEP; }
    __device__ __forceinline__ const char* bptr(const Unit& u) const { return B + (size_t)u.pn * BSTEP; }
    __device__ __forceinline__ char* optr(const Unit& u) const { return O + ((size_t)u.pm * 256 * LDC + (size_t)u.pn * 256) * OSZ; }
    __device__ __forceinline__ int ldc(const Unit&) const { return LDC; }
};
struct SchedGU {
    int G, c; const char* A; const char* B; char* Gb; char* Ub;
    __device__ __forceinline__ bool next(int i, Unit& u) const { return pg8::tile_of(i, G, c, M / 256, 44, u.pm, u.pn); }
    __device__ __forceinline__ const char* aptr(const Unit& u) const { return A + (size_t)u.pm * 256 * DM * 2; }
    __device__ __forceinline__ const char* bptr(const Unit& u) const { return B + (size_t)u.pn * 256 * DM * 2; }
    __device__ __forceinline__ char* optr(const Unit& u) const { char* ob = u.pn < 22 ? Gb : Ub; const int pc = u.pn < 22 ? u.pn : u.pn - 22; return ob + ((size_t)u.pm * 256 * FF + (size_t)pc * 256) * 2; }
    __device__ __forceinline__ int ldc(const Unit&) const { return FF; }
};
struct SchedKV {
    int G, c; const char* MEMH; const char* W; char* KVX;
    __device__ __forceinline__ bool next(int i, Unit& u) const { const int id = i * G + c; if (id >= 256) return false; u.pm = id >> 4; u.pn = id & 15; return true; }
    __device__ __forceinline__ const char* aptr(const Unit& u) const { return MEMH + (size_t)u.pm * 256 * DM * 2; }
    __device__ __forceinline__ const char* bptr(const Unit& u) const { return W + (size_t)u.pn * 256 * DM * 2; }
    __device__ __forceinline__ char* optr(const Unit& u) const { return KVX + ((size_t)u.pm * 256 * 4096 + (size_t)u.pn * 256) * 2; }
    __device__ __forceinline__ int ldc(const Unit&) const { return 4096; }
};
struct SchedQK {
    int G, c; const char* KVX; const char* WQ; char* WQK;
    __device__ __forceinline__ bool next(int i, Unit& u) const { const int id = i * G + c; if (id >= 512) return false; u.pm = id >> 3; u.pn = id & 7; return true; }
    __device__ __forceinline__ const char* aptr(const Unit& u) const { return KVX + ((size_t)(u.pm >> 2) * 256 * 4096 + (size_t)(u.pm & 3) * 512) * 2; }
    __device__ __forceinline__ const char* bptr(const Unit& u) const { return WQ + ((size_t)u.pn * 256 * DM + (size_t)(u.pm & 3) * 512) * 2; }
    __device__ __forceinline__ char* optr(const Unit& u) const { return WQK + ((size_t)u.pm * 256 * DM + (size_t)u.pn * 256) * 2; }
    __device__ __forceinline__ int ldc(const Unit&) const { return DM; }
};
struct SchedOV {
    int G, c; const char* WOT; const char* KVX; char* WOV;
    __device__ __forceinline__ bool next(int i, Unit& u) const { const int id = i * G + c; if (id >= 512) return false; u.pm = id >> 3; u.pn = id & 7; return true; }
    __device__ __forceinline__ const char* aptr(const Unit& u) const { return WOT + ((size_t)u.pn * 256 * DM + (size_t)(u.pm & 3) * 512) * 2; }
    __device__ __forceinline__ const char* bptr(const Unit& u) const { return KVX + ((size_t)(u.pm >> 2) * 256 * 4096 + 2048 + (size_t)(u.pm & 3) * 512) * 2; }
    __device__ __forceinline__ char* optr(const Unit& u) const { return WOV + ((size_t)(u.pm >> 2) * 2048 * 1024 + (size_t)u.pn * 256 * 1024 + (size_t)(u.pm & 3) * 256) * 2; }
    __device__ __forceinline__ int ldc(const Unit&) const { return 1024; }
};
struct SchedS {
    int G, c; const char* HN; const char* WQK; char* P;
    __device__ __forceinline__ bool next(int i, Unit& u) const { return pg8::tile_of(i, G, c, M / 256, 4, u.pm, u.pn); }
    __device__ __forceinline__ const char* aptr(const Unit& u) const { return HN + (size_t)u.pm * 256 * DM * 2; }
    __device__ __forceinline__ const char* bptr(const Unit& u) const { return WQK + (size_t)((u.pm >> 3) * 4 + u.pn) * 256 * DM * 2; }
    __device__ __forceinline__ char* optr(const Unit& u) const { return P + ((size_t)u.pm * 256 * 1024 + (size_t)u.pn * 256) * 2; }
    __device__ __forceinline__ int ldc(const Unit&) const { return 1024; }
};
struct SchedXO {
    int G, c; const char* P; const char* WOV;
    __device__ __forceinline__ bool next(int i, Unit& u) const { return pg8::tile_of(i, G, c, M / 256, 8, u.pm, u.pn); }
    __device__ __forceinline__ const char* aptr(const Unit& u) const { return P + (size_t)u.pm * 256 * 1024 * 2; }
    __device__ __forceinline__ const char* bptr(const Unit& u) const { return WOV + ((size_t)(u.pm >> 3) * 2048 * 1024 + (size_t)u.pn * 256 * 1024) * 2; }
    __device__ __forceinline__ char* optr(const Unit&) const { return nullptr; }
    __device__ __forceinline__ int ldc(const Unit&) const { return DM; }
};
struct SchedWf {
    int G, c; const char* WMOT; const char* WPS; char* WF;
    __device__ __forceinline__ bool next(int i, Unit& u) const { const int id = i * G + c; if (id >= 32) return false; u.pn = id >> 3; u.pm = id & 7; return true; }
    __device__ __forceinline__ const char* aptr(const Unit& u) const { return WMOT + ((size_t)u.pm * 256 * 1024 + (size_t)u.pn * 256) * 2; }
    __device__ __forceinline__ const char* bptr(const Unit& u) const { return WPS + (size_t)u.pn * 65536 * 2; }
    __device__ __forceinline__ char* optr(const Unit& u) const { return WF + ((size_t)u.pm * 256 * DM + (size_t)u.pn * 256) * 2; }
    __device__ __forceinline__ int ldc(const Unit&) const { return DM; }
};
struct SchedP {
    int G, c; const char* A; const char* B; char* PB;
    __device__ __forceinline__ bool next(int i, Unit& u) const { return pg8::tile_of(i, G, c, M / 256, 20, u.pm, u.pn); }
    __device__ __forceinline__ const char* aptr(const Unit& u) const { return A + (size_t)u.pm * 256 * DM * 2; }
    __device__ __forceinline__ const char* bptr(const Unit& u) const { return B + (size_t)u.pn * 256 * DM * 2; }
    __device__ __forceinline__ char* optr(const Unit& u) const { return PB + ((size_t)u.pm * 256 * PW + (size_t)u.pn * 256) * 2; }
    __device__ __forceinline__ int ldc(const Unit&) const { return PW; }
};

typedef SchedStd<M / 256, 8, DM, 4, (size_t)256 * DM * 2, (size_t)256 * DM * 2> SchedX;
typedef SchedStd<M / 256, 8, DM, 2, (size_t)256 * DM * 2, (size_t)256 * DM * 2> SchedQ;
typedef SchedStd<M / 256, 8, DM, 4, (size_t)256 * FF * 2, (size_t)256 * FF * 2> SchedD;

struct Ctx { LAS unsigned char* lds; int tid, lane, wave, gw, NGW; };

__device__ __forceinline__ void transpose_item(const float* W, int K, int N, int ldw, bf16_t* WT, int ldt, LAS float* scr, int item, int lane, int rmode = 0, const float* gk = nullptr) {
    const int nblk = (N + 63) / 64, kb = item / nblk, nb = item % nblk, k0 = 64 * kb, n0 = 64 * nb;
    const int col4 = (lane & 15) * 4, r4 = lane >> 4; const bool nok = (n0 + col4) < N;
    f32x4 v[16];
#pragma unroll
    for (int i = 0; i < 16; ++i) v[i] = nok ? *(const GAS f32x4*)((const GAS float*)W + (size_t)(k0 + 4 * i + r4) * ldw + n0 + col4) : (f32x4){0.f, 0.f, 0.f, 0.f};
#pragma unroll
    for (int i = 0; i < 16; ++i) { const int kk = 4 * i + r4; *(LAS f32x4*)(scr + kk * 64 + ((col4 + 4 * (kk >> 3)) & 63)) = v[i]; }
    LDS_WAIT(); asm volatile("" ::: "memory");
    const int c = lane & 7;
    f32x4 ga = (f32x4){1.f, 1.f, 1.f, 1.f}, gb = ga;
    if (gk) { ga = *(const f32x4*)(gk + k0 + 8 * c); gb = *(const f32x4*)(gk + k0 + 8 * c + 4); }
#pragma unroll
    for (int j = 0; j < 8; ++j) { const int n = (lane >> 3) + 8 * j; const LAS float* s = scr + (8 * c) * 64 + ((n + 4 * c) & 63);
        u32x4 o; o.x = cvt_pk_bf16(s[0 * 64] * ga[0], s[1 * 64] * ga[1]); o.y = cvt_pk_bf16(s[2 * 64] * ga[2], s[3 * 64] * ga[3]); o.z = cvt_pk_bf16(s[4 * 64] * gb[0], s[5 * 64] * gb[1]); o.w = cvt_pk_bf16(s[6 * 64] * gb[2], s[7 * 64] * gb[3]);
        const int nn = n0 + n, rho = rmode == 0 ? nn : ((nn >> 7) * 256 + (nn & 127) + (rmode == 2 ? 128 : 0));
        if (nn < N) *(GAS u32x4*)((GAS bf16_t*)WT + (size_t)rho * ldt + k0 + 8 * c) = o; }
    LDS_WAIT(); asm volatile("" ::: "memory");
}

struct NormGain { f32x4 g[4][2]; };
__device__ __forceinline__ NormGain norm_gain(const Ctx& C, const float* gain) { NormGain G;
#pragma unroll
    for (int j = 0; j < 4; ++j) { G.g[j][0] = *(const f32x4*)(gain + (C.lane + 64 * j) * 8); G.g[j][1] = *(const f32x4*)(gain + (C.lane + 64 * j) * 8 + 4); }
    return G; }
__device__ __forceinline__ float sumsq8(const f32x4 a, const f32x4 b) { return ((a[0] * a[0] + a[1] * a[1]) + (a[2] * a[2] + a[3] * a[3])) + ((b[0] * b[0] + b[1] * b[1]) + (b[2] * b[2] + b[3] * b[3])); }
__device__ __forceinline__ u32x4 pack8n(const f32x4 a, const f32x4 b, const float r, const f32x4 ga, const f32x4 gb) { u32x4 w;
    w.x = cvt_pk_bf16(a[0] * r * ga[0], a[1] * r * ga[1]); w.y = cvt_pk_bf16(a[2] * r * ga[2], a[3] * r * ga[3]); w.z = cvt_pk_bf16(b[0] * r * gb[0], b[1] * r * gb[1]); w.w = cvt_pk_bf16(b[2] * r * gb[2], b[3] * r * gb[3]); return w; }
__device__ __forceinline__ void rmsnorm_rows_bf16(const Ctx& C, const bf16_t* x, const float* gain, bf16_t* dst, int nrows) {
    const NormGain G = norm_gain(C, gain);
    for (int m = C.gw; m < nrows; m += C.NGW) {
        const u32x4* xr = (const u32x4*)(x + (size_t)m * DM) + C.lane;
        u32x4 r[4]; f32x4 v[4][2]; float s = 0.f;
#pragma unroll
        for (int j = 0; j < 4; ++j) r[j] = xr[64 * j];
#pragma unroll
        for (int j = 0; j < 4; ++j) { v[j][0] = (f32x4){bflo(r[j].x), bfhi(r[j].x), bflo(r[j].y), bfhi(r[j].y)}; v[j][1] = (f32x4){bflo(r[j].z), bfhi(r[j].z), bflo(r[j].w), bfhi(r[j].w)}; s += sumsq8(v[j][0], v[j][1]); }
        const float rstd = rsqrtf(wave_sum(s) * (1.f / DM) + EPS);
        u32x4* o = (u32x4*)(dst + (size_t)m * DM) + C.lane;
#pragma unroll
        for (int j = 0; j < 4; ++j) o[64 * j] = pack8n(v[j][0], v[j][1], rstd, G.g[j][0], G.g[j][1]);
    }
}
template <bool COPY> __device__ __forceinline__ void rmsnorm_rows_first(const Ctx& C, const float* x, const float* gain, bf16_t* dst, bf16_t* xcopy, int nrows) {
    const NormGain G = norm_gain(C, gain);
    for (int m = C.gw; m < nrows; m += C.NGW) {
        const f32x4* xr = (const f32x4*)(x + (size_t)m * DM) + 2 * C.lane;
        f32x4 v[4][2]; float s = 0.f;
#pragma unroll
        for (int j = 0; j < 4; ++j) { v[j][0] = xr[128 * j]; v[j][1] = xr[128 * j + 1]; }
#pragma unroll
        for (int j = 0; j < 4; ++j) s += sumsq8(v[j][0], v[j][1]);
        const float rstd = rsqrtf(wave_sum(s) * (1.f / DM) + EPS);
        u32x4* o = (u32x4*)(dst + (size_t)m * DM) + C.lane; u32x4* xc = (u32x4*)(xcopy + (size_t)m * DM) + C.lane;
        const f32x4 one = (f32x4){1.f, 1.f, 1.f, 1.f};
#pragma unroll
        for (int j = 0; j < 4; ++j) { o[64 * j] = pack8n(v[j][0], v[j][1], rstd, G.g[j][0], G.g[j][1]); if (COPY) xc[64 * j] = pack8n(v[j][0], v[j][1], 1.0f, one, one); }
    }
}
__device__ __forceinline__ void x_first(const Ctx& C, const float* x, bf16_t* xcopy, float* rstd, int nrows) {
    for (int m = C.gw; m < nrows; m += C.NGW) {
        const f32x4* xr = (const f32x4*)(x + (size_t)m * DM) + 2 * C.lane;
        f32x4 v[4][2]; float s = 0.f;
#pragma unroll
        for (int j = 0; j < 4; ++j) { v[j][0] = xr[128 * j]; v[j][1] = xr[128 * j + 1]; }
#pragma unroll
        for (int j = 0; j < 4; ++j) s += sumsq8(v[j][0], v[j][1]);
        s = wave_sum(s);
        u32x4* xc = (u32x4*)(xcopy + (size_t)m * DM) + C.lane; const f32x4 one = (f32x4){1.f, 1.f, 1.f, 1.f};
#pragma unroll
        for (int j = 0; j < 4; ++j) xc[64 * j] = pack8n(v[j][0], v[j][1], 1.0f, one, one);
        if (C.lane == 0) rstd[m] = rsqrtf(s * (1.f / DM) + EPS);
    }
}
__device__ __forceinline__ void rstd_finish(const Ctx& C, const float* ssq, float* rstd, int nrows) {
    for (int m = C.gw * 64 + C.lane; m < nrows; m += C.NGW * 64) { const f32x4* p = (const f32x4*)(ssq + (size_t)m * 32); f32x4 t = p[0];
#pragma unroll
        for (int j = 1; j < 8; ++j) t = t + p[j];
        rstd[m] = rsqrtf(((t[0] + t[1]) + (t[2] + t[3])) * (1.f / DM) + EPS); }
}
__device__ __forceinline__ void rmsnorm_rows_f32(const Ctx& C, const bf16_t* x, float* out, const float* gain, int nrows) {
    const NormGain G = norm_gain(C, gain);
    for (int m = C.gw; m < nrows; m += C.NGW) {
        const u32x4* xr = (const u32x4*)(x + (size_t)m * DM) + C.lane;
        u32x4 r[4]; f32x4 v[4][2]; float s = 0.f;
#pragma unroll
        for (int j = 0; j < 4; ++j) r[j] = xr[64 * j];
#pragma unroll
        for (int j = 0; j < 4; ++j) { v[j][0] = (f32x4){bflo(r[j].x), bfhi(r[j].x), bflo(r[j].y), bfhi(r[j].y)}; v[j][1] = (f32x4){bflo(r[j].z), bfhi(r[j].z), bflo(r[j].w), bfhi(r[j].w)}; s += sumsq8(v[j][0], v[j][1]); }
        const float rstd = rsqrtf(wave_sum(s) * (1.f / DM) + EPS);
        f32x4* o = (f32x4*)(out + (size_t)m * DM) + 2 * C.lane;
#pragma unroll
        for (int j = 0; j < 4; ++j) { o[128 * j] = v[j][0] * rstd * G.g[j][0]; o[128 * j + 1] = v[j][1] * rstd * G.g[j][1]; }
    }
}

typedef short v4i16_t __attribute__((ext_vector_type(4)));
__device__ __forceinline__ u32x2 lds_tr16(const LAS unsigned char* p) {
    return __builtin_bit_cast(u32x2, __builtin_amdgcn_ds_read_tr16_b64_v4i16((LAS v4i16_t*)p)); }
__device__ __forceinline__ f32x4 mfma16(bf16x8 a, bf16x8 b, f32x4 c) { return __builtin_amdgcn_mfma_f32_16x16x32_bf16(a, b, c, 0, 0, 0); }
__device__ __forceinline__ bf16x8 pack8(const f32x4 lo, const f32x4 hi) { u32x4 w; w.x = cvt_pk_bf16_c(lo[0], lo[1]); w.y = cvt_pk_bf16_c(lo[2], lo[3]); w.z = cvt_pk_bf16_c(hi[0], hi[1]); w.w = cvt_pk_bf16_c(hi[2], hi[3]); return __builtin_bit_cast(bf16x8, w); }
__device__ __forceinline__ bf16x8 join8(const u32x2 lo, const u32x2 hi) { u32x4 w; w.x = lo.x; w.y = lo.y; w.z = hi.x; w.w = hi.y; return __builtin_bit_cast(bf16x8, w); }

__device__ __forceinline__ void logits16(const int lane_, const bf16_t* x, const bf16_t* wlt, const float* rstd, float* logit, const int blk) {
    int lane = lane_; asm volatile("" : "+v"(lane));
    const int c15 = lane & 15, g4 = lane >> 4;
    const GAS bf16_t* xa = (const GAS bf16_t*)x + (size_t)(16 * blk + c15) * DM + 8 * g4;
    const GAS bf16_t* wb = (const GAS bf16_t*)wlt + (size_t)c15 * DM + 8 * g4;
    f32x4 acc0 = (f32x4){0.f, 0.f, 0.f, 0.f}, acc1 = acc0;
#pragma unroll 1
    for (int k0 = 0; k0 < DM / 32; k0 += 16) {
        bf16x8 a[16], bb[16];
#pragma unroll
        for (int i = 0; i < 16; ++i) { a[i] = *(const GAS bf16x8*)(xa + 32 * (k0 + i)); bb[i] = *(const GAS bf16x8*)(wb + 32 * (k0 + i)); }
#pragma unroll
        for (int i = 0; i < 16; i += 2) { acc0 = mfma16(a[i], bb[i], acc0); acc1 = mfma16(a[i + 1], bb[i + 1], acc1); }
    }
    const f32x4 rs = *(const GAS f32x4*)((const GAS float*)rstd + 16 * blk + 4 * g4);
    const f32x4 v = (acc0 + acc1) * rs;
    GAS float* lp = (GAS float*)logit + (size_t)(16 * blk + 4 * g4) * 16 + c15;
#pragma unroll
    for (int r = 0; r < 4; ++r) lp[r * 16] = v[r];
}

template <int SEC> __device__ __forceinline__ void dn_conv_sec(const int lane, const unsigned zv, const bf16_t* pq, const float* cwq, bf16_t* dq, const bool seqstart) {
    const int c15 = lane & 15, g4 = lane >> 4;
    const GAS bf16_t* src = (const GAS bf16_t*)pq + (size_t)(16 * g4 - 3) * PW + SEC * 1024 + c15 * 8;
    GAS bf16_t* dst = (GAS bf16_t*)dq + (size_t)(16 * g4) * 3072 + SEC * 1024 + c15 * 8;
    const bool nohist = seqstart && g4 == 0;
    u32x4 raw[19];
#pragma unroll
    for (int i = 0; i < 19; ++i) { raw[i] = (u32x4){zv, zv, zv, zv}; if (i >= 3 || !nohist) raw[i] = *(const GAS u32x4*)(src + (size_t)i * PW); }
    constexpr float NL2E = -1.4426950408889634f, LN2 = 0.6931471805599453f;
    float wk[4][8];
#pragma unroll
    for (int k = 0; k < 4; ++k) { const f32x4 w0 = *(const GAS f32x4*)((const GAS float*)cwq + k * 3072 + SEC * 1024 + c15 * 8), w1 = *(const GAS f32x4*)((const GAS float*)cwq + k * 3072 + SEC * 1024 + c15 * 8 + 4);
        wk[k][0] = w0[0] * NL2E; wk[k][1] = w0[1] * NL2E; wk[k][2] = w0[2] * NL2E; wk[k][3] = w0[3] * NL2E; wk[k][4] = w1[0] * NL2E; wk[k][5] = w1[1] * NL2E; wk[k][6] = w1[2] * NL2E; wk[k][7] = w1[3] * NL2E; }
#define DN_UNPACK(d, q) do { d[0] = bflo(q.x); d[1] = bfhi(q.x); d[2] = bflo(q.y); d[3] = bfhi(q.y); d[4] = bflo(q.z); d[5] = bfhi(q.z); d[6] = bflo(q.w); d[7] = bfhi(q.w); } while (0)
    float p1[8], p2[8], p3[8];
    DN_UNPACK(p3, raw[0]); DN_UNPACK(p2, raw[1]); DN_UNPACK(p1, raw[2]);
#pragma unroll
    for (int i = 0; i < 16; ++i) {
        float c[8], u[8], ss = 0.f;
        DN_UNPACK(c, raw[i + 3]);
#pragma unroll
        for (int e = 0; e < 8; ++e) { const float yp = wk[3][e] * c[e] + wk[2][e] * p1[e] + wk[1][e] * p2[e] + wk[0][e] * p3[e];
            u[e] = yp * __builtin_amdgcn_rcpf(1.0f + __builtin_amdgcn_exp2f(yp)); ss += u[e] * u[e]; }
        float sc = -LN2;
        if (SEC < 2) { ss += sx<1>(ss); ss += sx<2>(ss); ss += sx<4>(ss); ss += sx<8>(ss); sc = -rsqrtf(ss + EPS * (NL2E * NL2E)) * (SEC == 0 ? 0.08838834764831845f : 1.0f); }
        u32x4 o; o.x = cvt_pk_bf16(u[0] * sc, u[1] * sc); o.y = cvt_pk_bf16(u[2] * sc, u[3] * sc); o.z = cvt_pk_bf16(u[4] * sc, u[5] * sc); o.w = cvt_pk_bf16(u[6] * sc, u[7] * sc);
        *(GAS u32x4*)(dst + (size_t)i * 3072) = o;
#pragma unroll
        for (int e = 0; e < 8; ++e) { p3[e] = p2[e]; p2[e] = p1[e]; p1[e] = c[e]; }
    }
#undef DN_UNPACK
}
__device__ __forceinline__ void dn_conv_qkv(const bf16_t* pq, const float* cwq, bf16_t* dq, const int m0) {
    unsigned zv = 0u; asm volatile("" : "+v"(zv));
    const int lane = (int)__builtin_amdgcn_mbcnt_hi(~0u, __builtin_amdgcn_mbcnt_lo(~0u, zv));
    const bool seqstart = (m0 & (SEQ - 1)) == 0;
    dn_conv_sec<0>(lane, zv, pq, cwq, dq, seqstart); asm volatile("" ::: "memory");
    dn_conv_sec<1>(lane, zv, pq, cwq, dq, seqstart); asm volatile("" ::: "memory");
    dn_conv_sec<2>(lane, zv, pq, cwq, dq, seqstart);
    asm volatile("s_waitcnt vmcnt(0)" ::: "memory");
}

__device__ __forceinline__ void dn_chunk_prep(const int wave, const unsigned lds_base, const bf16_t* qkv, const float* logit, const float nea, const float dtb, unsigned char* rec, const int m0, const int h) {
    unsigned zv = 0u; asm volatile("" : "+v"(zv));
    const int lane = (int)__builtin_amdgcn_mbcnt_hi(~0u, __builtin_amdgcn_mbcnt_lo(~0u, zv)); const float zf = __uint_as_float(zv);
    LAS unsigned char* scr; { unsigned sb = lds_base + (unsigned)wave * 17408u + zv; asm volatile("" : "+v"(sb)); scr = (LAS unsigned char*)(size_t)sb; }
    const int c15 = lane & 15, g4 = lane >> 4;
    LAS float* LtS = (LAS float*)scr;
    LAS float* GCs = (LAS float*)(scr + 16384);
    LAS float* BTs = GCs + 64;
    LAS float* BEs = BTs + 64;
    const GAS float* lgp = (const GAS float*)logit + (size_t)(m0 + lane) * 16 + h;
    const float blr = lgp[0], alr = lgp[8] + dtb;
    const float bl = 1.0f / (1.0f + __expf(-blr));
    float gc = nea * (fmaxf(alr, 0.f) + log1pf(__expf(-fabsf(alr))));
#pragma unroll
    for (int o = 1; o < 64; o <<= 1) { const float t = __builtin_bit_cast(float, __builtin_amdgcn_ds_bpermute((lane - o) << 2, __builtin_bit_cast(int, gc))); if (lane >= o) gc += t; }
    const float gcl = __builtin_bit_cast(float, __builtin_amdgcn_readlane(__builtin_bit_cast(int, gc), 63));
    GCs[lane] = gc; BTs[lane] = bl; BEs[lane] = bl * __expf(gc);
    asm volatile("" ::: "memory");
    { GAS float* mo = (GAS float*)(rec + REC_MISC); mo[lane] = __expf(gc); mo[64 + lane] = __expf(gcl - gc); if (lane == 0) mo[128] = __expf(gcl); }
    const GAS bf16_t* qb = (const GAS bf16_t*)qkv + (size_t)m0 * 3072 + h * 128;
    bf16x8 Kf[4][4], Qf[4][4];
#pragma unroll
    for (int rt = 0; rt < 4; ++rt)
#pragma unroll
        for (int ks = 0; ks < 4; ++ks) { Kf[rt][ks] = *(const GAS bf16x8*)(qb + (size_t)(16 * rt + c15) * 3072 + 1024 + 32 * ks + 8 * g4); Qf[rt][ks] = *(const GAS bf16x8*)(qb + (size_t)(16 * rt + c15) * 3072 + 32 * ks + 8 * g4); }
    float gcc[4];
    f32x4 gcr[4], btr[4];
#pragma unroll
    for (int t = 0; t < 4; ++t) { gcc[t] = GCs[16 * t + c15]; gcr[t] = *(const LAS f32x4*)(GCs + 16 * t + 4 * g4); btr[t] = *(const LAS f32x4*)(BTs + 16 * t + 4 * g4); }
#pragma unroll
    for (int jt = 0; jt < 4; ++jt)
#pragma unroll
        for (int ct = 0; ct <= jt; ++ct) {
            f32x4 d = (f32x4){0.f, 0.f, 0.f, 0.f};
#pragma unroll
            for (int ks = 0; ks < 4; ++ks) d = mfma16(Kf[jt][ks], Kf[ct][ks], d);
            const int c = 16 * ct + c15, j0 = 16 * jt + 4 * g4; f32x4 lv;
#pragma unroll
            for (int r = 0; r < 4; ++r) { lv[r] = btr[jt][r] * d[r] * __expf(fminf(gcr[jt][r] - gcc[ct], 0.f)); if (jt == ct && !(4 * g4 + r > c15)) lv[r] = 0.f; }
            if (jt >= 2 && ct < 2) { u32x2 w; w.x = cvt_pk_bf16(lv[0], lv[1]); w.y = cvt_pk_bf16(lv[2], lv[3]); *(LAS u32x2*)(scr + c * 256 + 128 + (j0 - 32) * 2) = w; }
            else *(LAS f32x4*)(LtS + c * 64 + j0) = lv;
        }
    { GAS bf16_t* ao = (GAS bf16_t*)(rec + REC_AT);
#pragma unroll
      for (int it = 0; it < 4; ++it) {
#pragma unroll
        for (int jt = 0; jt < 4; ++jt) {
            u32x2 w = (u32x2){zv, zv};
            if (it >= jt) {
                f32x4 d = (f32x4){0.f, 0.f, 0.f, 0.f};
#pragma unroll
                for (int ks = 0; ks < 4; ++ks) d = mfma16(Kf[jt][ks], Qf[it][ks], d);
                float v[4];
#pragma unroll
                for (int r = 0; r < 4; ++r) { v[r] = d[r] * __expf(fminf(gcc[it] - gcr[jt][r], 0.f)); if (it == jt && !(c15 >= 4 * g4 + r)) v[r] = 0.f; }
                w.x = cvt_pk_bf16(v[0], v[1]); w.y = cvt_pk_bf16(v[2], v[3]);
            }
            *(GAS u32x2*)(ao + (size_t)(16 * it + c15) * 64 + 16 * jt + 4 * g4) = w;
        } } }
#pragma unroll
    for (int jt = 0; jt < 3; jt += 2) *(LAS f32x4*)(LtS + (16 * (jt + 1) + c15) * 64 + 16 * jt + 4 * g4) = (f32x4){zf, zf, zf, zf};
    asm volatile("" ::: "memory");
    __builtin_amdgcn_sched_barrier(0);
    float T[32];
    LAS unsigned char* hp; { unsigned hb = lds_base + (unsigned)wave * 17408u + (unsigned)(lane >> 5) * 8320u; asm volatile("" : "+v"(hb)); hp = (LAS unsigned char*)(size_t)hb; }
    int lb = (lane & 31) * 4;
#pragma unroll
    for (int c = 31; c >= 0; --c) {
        if ((c & 7) == 7 && c < 31) asm volatile("" : "+v"(lb) : "v"(T[c + 1]) : "memory");
        float a0 = -*(const LAS float*)(hp + c * 256 + lb), a1 = 0.f;
#pragma unroll
        for (int q = 7; q >= (c + 1) / 4; --q) {
            const f32x4 lv = *(const LAS f32x4*)(hp + c * 256 + 16 * q);
#pragma unroll
            for (int e = 3; e >= 0; --e) { const int j = 4 * q + e; if (j > c) { if (j & 1) a1 = __builtin_fmaf(-T[j], lv[e], a1); else a0 = __builtin_fmaf(-T[j], lv[e], a0); } }
        }
        T[c] = a0 + a1;
    }
    __builtin_amdgcn_sched_barrier(0);
    asm volatile("" ::: "memory");
    int lane2 = lane; asm volatile("" : "+v"(lane2));
    const int c15b = lane2 & 15, g4b = lane2 >> 4, hf2 = lane2 >> 5, rl2 = lane2 & 31; float zf2 = zf; asm volatile("" : "+v"(zf2));
#pragma unroll
    for (int j8 = 0; j8 < 4; ++j8) { float v[8];
#pragma unroll
        for (int e = 0; e < 8; ++e) v[e] = (8 * j8 + e == rl2) ? 1.0f : T[8 * j8 + e];
        u32x4 w; w.x = cvt_pk_bf16(v[0], v[1]); w.y = cvt_pk_bf16(v[2], v[3]); w.z = cvt_pk_bf16(v[4], v[5]); w.w = cvt_pk_bf16(v[6], v[7]);
        *(LAS u32x4*)(scr + lane2 * 256 + hf2 * 128 + j8 * 16) = w; }
    asm volatile("" ::: "memory");
    f32x4 T21[2][2];
    { bf16x8 Al[2], Bt[2], A2[2];
#pragma unroll
      for (int t = 0; t < 2; ++t) { const LAS unsigned char* pB = scr + (8 * g4b + (c15b >> 2)) * 256 + (16 * t + 4 * (c15b & 3)) * 2;
          Bt[t] = join8(lds_tr16(pB), lds_tr16(pB + 4 * 256)); Al[t] = join8(lds_tr16(pB + 128), lds_tr16(pB + 128 + 4 * 256));
          const LAS unsigned char* pT = scr + (32 + 16 * t + c15b) * 256 + 128 + 8 * g4b; A2[t] = join8(*(const LAS u32x2*)pT, *(const LAS u32x2*)(pT + 32)); }
      f32x4 X[2][2];
#pragma unroll
      for (int jt = 0; jt < 2; ++jt)
#pragma unroll
          for (int ct = 0; ct < 2; ++ct) X[jt][ct] = mfma16(Al[jt], Bt[ct], (f32x4){0.f, 0.f, 0.f, 0.f});
#pragma unroll
      for (int ct = 0; ct < 2; ++ct) { const bf16x8 BX = pack8(X[0][ct], X[1][ct]);
#pragma unroll
          for (int it = 0; it < 2; ++it) T21[it][ct] = mfma16(A2[it], BX, (f32x4){0.f, 0.f, 0.f, 0.f}); } }
    u32x4 vst[16];
#pragma unroll
    for (int p = 0; p < 16; ++p) vst[p] = *(const GAS u32x4*)(qb + 2048 + (size_t)(4 * p + g4b) * 3072 + c15b * 8);
    asm volatile("s_waitcnt lgkmcnt(0)" ::: "memory");
    LAS bf16_t* TuS = (LAS bf16_t*)scr; LAS bf16_t* TwS = TuS + 64 * 64;
#pragma unroll
    for (int j8 = 0; j8 < 4; ++j8) {
        const LAS float* bp = BTs + 32 * hf2 + 8 * j8; const LAS float* ep = BEs + 32 * hf2 + 8 * j8;
        const f32x4 b0 = *(const LAS f32x4*)bp, b1 = *(const LAS f32x4*)(bp + 4), e0 = *(const LAS f32x4*)ep, e1 = *(const LAS f32x4*)(ep + 4);
        u32x4 wu, ww;
        wu.x = cvt_pk_bf16(T[8 * j8] * b0[0], T[8 * j8 + 1] * b0[1]); wu.y = cvt_pk_bf16(T[8 * j8 + 2] * b0[2], T[8 * j8 + 3] * b0[3]);
        wu.z = cvt_pk_bf16(T[8 * j8 + 4] * b1[0], T[8 * j8 + 5] * b1[1]); wu.w = cvt_pk_bf16(T[8 * j8 + 6] * b1[2], T[8 * j8 + 7] * b1[3]);
        ww.x = cvt_pk_bf16(-T[8 * j8] * e0[0], -T[8 * j8 + 1] * e0[1]); ww.y = cvt_pk_bf16(-T[8 * j8 + 2] * e0[2], -T[8 * j8 + 3] * e0[3]);
        ww.z = cvt_pk_bf16(-T[8 * j8 + 4] * e1[0], -T[8 * j8 + 5] * e1[1]); ww.w = cvt_pk_bf16(-T[8 * j8 + 6] * e1[2], -T[8 * j8 + 7] * e1[3]);
        *(LAS u32x4*)(TuS + lane2 * 64 + 32 * hf2 + 8 * j8) = wu; *(LAS u32x4*)(TwS + lane2 * 64 + 32 * hf2 + 8 * j8) = ww;
        if (hf2 == 0) { *(LAS u32x4*)(TuS + lane2 * 64 + 32 + 8 * j8) = (u32x4){zv, zv, zv, zv}; *(LAS u32x4*)(TwS + lane2 * 64 + 32 + 8 * j8) = (u32x4){zv, zv, zv, zv}; }
    }
#pragma unroll
    for (int ct = 0; ct < 2; ++ct) {
        const float nb = -BTs[16 * ct + c15b], pe = BEs[16 * ct + c15b];
#pragma unroll
        for (int it = 0; it < 2; ++it) { const f32x4 du = T21[it][ct] * nb, dw = T21[it][ct] * pe;
            const unsigned u01 = cvt_pk_bf16(du[0], du[1]), u23 = cvt_pk_bf16(du[2], du[3]), w01 = cvt_pk_bf16(dw[0], dw[1]), w23 = cvt_pk_bf16(dw[2], dw[3]);
            LAS unsigned short* pu = (LAS unsigned short*)(TuS + (32 + 16 * it + 4 * g4b) * 64 + 16 * ct + c15b); LAS unsigned short* pw = (LAS unsigned short*)(TwS + (32 + 16 * it + 4 * g4b) * 64 + 16 * ct + c15b);
            pu[0] = (unsigned short)(u01 & 0xffffu); pu[64] = (unsigned short)(u01 >> 16); pu[128] = (unsigned short)(u23 & 0xffffu); pu[192] = (unsigned short)(u23 >> 16);
            pw[0] = (unsigned short)(w01 & 0xffffu); pw[64] = (unsigned short)(w01 >> 16); pw[128] = (unsigned short)(w23 & 0xffffu); pw[192] = (unsigned short)(w23 >> 16); } }
    float btc[4], bec[4];
#pragma unroll
    for (int t = 0; t < 4; ++t) { btc[t] = BTs[16 * t + c15b]; bec[t] = -BEs[16 * t + c15b]; }
    asm volatile("" ::: "memory");
    bf16x8 Tuf[4][2], Twf[4][2];
#pragma unroll
    for (int it = 0; it < 4; ++it)
#pragma unroll
        for (int k2 = 0; k2 < 2; ++k2) { Tuf[it][k2] = *(const LAS bf16x8*)(TuS + (16 * it + c15b) * 64 + 32 * k2 + 8 * g4b); Twf[it][k2] = *(const LAS bf16x8*)(TwS + (16 * it + c15b) * 64 + 32 * k2 + 8 * g4b); }
#define DN_XT_PASS(TF, SCV, DSTOFF) do { GAS bf16_t* dst = (GAS bf16_t*)(rec + (DSTOFF)); \
        _Pragma("unroll") for (int et = 0; et < 8; ++et) { bf16x8 A[2]; \
            _Pragma("unroll") for (int k2 = 0; k2 < 2; ++k2) { const LAS unsigned char* p0 = scr + (32 * k2 + 8 * g4b + (c15b >> 2)) * 256 + (16 * et + 4 * (c15b & 3)) * 2; A[k2] = join8(lds_tr16(p0), lds_tr16(p0 + 4 * 256)); } \
            _Pragma("unroll") for (int it = 0; it < 4; ++it) { \
                const u32x2 xi = *(const LAS u32x2*)(scr + (16 * it + c15b) * 256 + (16 * et + 4 * g4b) * 2); const float sc = SCV[it]; \
                f32x4 d = (f32x4){sc * bflo(xi.x), sc * bfhi(xi.x), sc * bflo(xi.y), sc * bfhi(xi.y)}; \
                d = mfma16(A[0], TF[it][0], d); d = mfma16(A[1], TF[it][1], d); \
                d = d + zf2;                                    \
                u32x2 w; w.x = cvt_pk_bf16(d[0], d[1]); w.y = cvt_pk_bf16(d[2], d[3]); \
                *(GAS u32x2*)(dst + (size_t)(16 * it + c15b) * 128 + 16 * et + 4 * g4b) = w; } } } while (0)
    asm volatile("s_waitcnt lgkmcnt(0)" ::: "memory");
#pragma unroll
    for (int p = 0; p < 16; ++p) *(LAS u32x4*)(scr + p * 1024 + lane2 * 16) = vst[p];
    asm volatile("" ::: "memory");
    u32x4 kst[16];
#pragma unroll
    for (int p = 0; p < 16; ++p) kst[p] = *(const GAS u32x4*)(qb + 1024 + (size_t)(4 * p + g4b) * 3072 + c15b * 8);
    DN_XT_PASS(Tuf, btc, REC_U);
    asm volatile("s_waitcnt lgkmcnt(0)" ::: "memory");
#pragma unroll
    for (int p = 0; p < 16; ++p) *(LAS u32x4*)(scr + p * 1024 + lane2 * 16) = kst[p];
    asm volatile("" ::: "memory");
    DN_XT_PASS(Twf, bec, REC_NW);
#undef DN_XT_PASS
    asm volatile("s_waitcnt lgkmcnt(0)" ::: "memory");
}

constexpr int DN_P = 272, DN_PA = 144;
constexpr int DN_NW = 0, DN_Q = 64 * DN_P, DN_K = 2 * 64 * DN_P, DN_U = 3 * 64 * DN_P, DN_AT = 4 * 64 * DN_P, DN_MISC = DN_AT + 64 * DN_PA, DN_Z = DN_MISC + 1024, DN_SLOT = DN_Z + 64 * DN_P, DN_RSTD = DN_SLOT + 4096, DN_YT = DN_RSTD + 512, DN_LDS = DN_YT + 8 * 2048;
__device__ __forceinline__ void dn_scan(const int tid, LAS unsigned char* lds, const bf16_t* qkv, const unsigned char* recs, const bf16_t* pbuf, bf16_t* amix, const float* gnorm, const int b, const int h) {
    const int lane = tid & 63, w = __builtin_amdgcn_readfirstlane(tid >> 6), c15 = lane & 15, g4 = lane >> 4;
    f32x4 S[8];
#pragma unroll
    for (int dt = 0; dt < 8; ++dt) S[dt] = (f32x4){0.f, 0.f, 0.f, 0.f};
    const float gn = gnorm[16 * w + c15];
    f32x4 oprev[4]; u32x2 zprev[4];
#pragma unroll
    for (int rt = 0; rt < 4; ++rt) { oprev[rt] = (f32x4){0.f, 0.f, 0.f, 0.f}; zprev[rt] = (u32x2){0u, 0u}; }
    u32x4 rNW[2], rQ[2], rK[2], rU[2], rZ[2], rAT; float rM = 0.f;
    const unsigned char* rec0 = recs + (size_t)((b * 8 + h) * 32) * REC_BYTES;
#define DN_LOAD(n) do { const GAS unsigned char* rc = (const GAS unsigned char*)rec0 + (size_t)(n) * REC_BYTES; const GAS bf16_t* qb = (const GAS bf16_t*)qkv + (size_t)(b * SEQ + (n) * 64) * 3072 + h * 128; \
        const GAS bf16_t* zb = (const GAS bf16_t*)pbuf + (size_t)(b * SEQ + (n) * 64) * PW + 4096 + h * 128; \
        _Pragma("unroll") for (int i = 0; i < 2; ++i) { const int c = tid + 512 * i, row = c >> 4, col = c & 15; \
            rNW[i] = *(const GAS u32x4*)(rc + REC_NW + c * 16); rU[i] = *(const GAS u32x4*)(rc + REC_U + c * 16); rZ[i] = *(const GAS u32x4*)(zb + (size_t)row * PW + col * 8); \
            rQ[i] = *(const GAS u32x4*)(qb + (size_t)row * 3072 + col * 8); rK[i] = *(const GAS u32x4*)(qb + (size_t)row * 3072 + 1024 + col * 8); } \
        rAT = *(const GAS u32x4*)(rc + REC_AT + tid * 16); if (tid < 132) rM = ((const GAS float*)(rc + REC_MISC))[tid]; } while (0)
#define DN_RSTD(par) do { if (tid < 64) { const LAS float* sl = (const LAS float*)(lds + DN_SLOT) + (par) * 512 + tid; float t = 0.f; _Pragma("unroll") for (int ww = 0; ww < 8; ++ww) t += sl[ww * 64]; \
        ((LAS float*)(lds + DN_RSTD))[(par) * 64 + tid] = rsqrtf(t * (1.0f / 128.0f) + EPS); } } while (0)
#define DN_FINAL(par, nprev) do { LAS unsigned char* yt = lds + DN_YT + w * 2048; \
        _Pragma("unroll") for (int rt = 0; rt < 4; ++rt) { const f32x4 rs = *(const LAS f32x4*)((const LAS float*)(lds + DN_RSTD) + (par) * 64 + 16 * rt + 4 * g4); \
            const float zz[4] = {bflo(zprev[rt].x), bfhi(zprev[rt].x), bflo(zprev[rt].y), bfhi(zprev[rt].y)}; \
            _Pragma("unroll") for (int r = 0; r < 4; ++r) { const float y = oprev[rt][r] * rs[r] * gn * silu_f(zz[r]); \
                *(LAS unsigned short*)(yt + (16 * rt + 4 * g4 + r) * 32 + c15 * 2) = (unsigned short)(cvt_pk_bf16_c(y, 0.f) & 0xffffu); } } \
        asm volatile("s_waitcnt lgkmcnt(0)" ::: "memory");            \
        GAS bf16_t* yb = (GAS bf16_t*)amix + (size_t)(b * SEQ + (nprev) * 64) * DM + 1024 + h * 128 + 16 * w; \
        _Pragma("unroll") for (int j = 0; j < 2; ++j) { const int tk = (lane >> 1) + 32 * j, hf = lane & 1; \
            const u32x4 v = *(const LAS u32x4*)(yt + tk * 32 + hf * 16); *(GAS u32x4*)(yb + (size_t)tk * DM + 8 * hf) = v; } \
        asm volatile("" ::: "memory"); } while (0)
    DN_LOAD(0);
#pragma unroll 1
    for (int n = 0; n < SEQ / 64; ++n) {
        __syncthreads();
#pragma unroll
        for (int i = 0; i < 2; ++i) { const int c = tid + 512 * i, row = c >> 4, col = c & 15; const int o = row * DN_P + col * 16;
            *(LAS u32x4*)(lds + DN_NW + o) = rNW[i]; *(LAS u32x4*)(lds + DN_Q + o) = rQ[i]; *(LAS u32x4*)(lds + DN_K + o) = rK[i]; *(LAS u32x4*)(lds + DN_U + o) = rU[i]; *(LAS u32x4*)(lds + DN_Z + o) = rZ[i]; }
        *(LAS u32x4*)(lds + DN_AT + (tid >> 3) * DN_PA + (tid & 7) * 16) = rAT;
        if (tid < 132) ((LAS float*)(lds + DN_MISC))[tid] = rM;
        if (n > 0) DN_RSTD((n - 1) & 1);
        __syncthreads();
        if (n + 1 < SEQ / 64) DN_LOAD(n + 1);
        if (n > 0) DN_FINAL((n - 1) & 1, n - 1);
        const LAS float* ms = (const LAS float*)(lds + DN_MISC);
        const float cdec = ms[128];
        bf16x8 BS[4];
#pragma unroll
        for (int ks = 0; ks < 4; ++ks) BS[ks] = pack8(S[2 * ks], S[2 * ks + 1]);
#define DN_APERM(off, pitch, rt, ks) join8(*(const LAS u32x2*)(lds + (off) + (16 * (rt) + c15) * (pitch) + (32 * (ks) + 4 * g4) * 2), *(const LAS u32x2*)(lds + (off) + (16 * (rt) + c15) * (pitch) + (32 * (ks) + 16 + 4 * g4) * 2))
        f32x4 vn[4], oq[4];
#pragma unroll
        for (int rt = 0; rt < 4; ++rt) { const u32x2 uu = lds_tr16(lds + DN_U + (16 * rt + 4 * g4 + (c15 >> 2)) * DN_P + (16 * w + 4 * (c15 & 3)) * 2);
            zprev[rt] = lds_tr16(lds + DN_Z + (16 * rt + 4 * g4 + (c15 >> 2)) * DN_P + (16 * w + 4 * (c15 & 3)) * 2);
            vn[rt] = (f32x4){bflo(uu.x), bfhi(uu.x), bflo(uu.y), bfhi(uu.y)}; oq[rt] = (f32x4){0.f, 0.f, 0.f, 0.f}; }
        { bf16x8 an[4], aq[4];
#pragma unroll
          for (int ks = 0; ks < 4; ++ks) {
#pragma unroll
              for (int rt = 0; rt < 4; ++rt) { an[rt] = DN_APERM(DN_NW, DN_P, rt, ks); aq[rt] = DN_APERM(DN_Q, DN_P, rt, ks); }
              __builtin_amdgcn_sched_barrier(0);
#pragma unroll
              for (int rt = 0; rt < 4; ++rt) { vn[rt] = mfma16(an[rt], BS[ks], vn[rt]); oq[rt] = mfma16(aq[rt], BS[ks], oq[rt]); }
              __builtin_amdgcn_sched_barrier(0);
          } }
        bf16x8 BV[2];
#pragma unroll
        for (int k2 = 0; k2 < 2; ++k2) BV[k2] = pack8(vn[2 * k2], vn[2 * k2 + 1]);
        f32x4 oa[4];
        { bf16x8 at[4][2];
#pragma unroll
          for (int rt = 0; rt < 4; ++rt)
#pragma unroll
              for (int k2 = 0; k2 < 2; ++k2) at[rt][k2] = DN_APERM(DN_AT, DN_PA, rt, k2);
          __builtin_amdgcn_sched_barrier(0);
#pragma unroll
          for (int rt = 0; rt < 4; ++rt) { oa[rt] = (f32x4){0.f, 0.f, 0.f, 0.f};
#pragma unroll
              for (int k2 = 0; k2 < 2; ++k2) oa[rt] = mfma16(at[rt][k2], BV[k2], oa[rt]); }
          __builtin_amdgcn_sched_barrier(0); }
        float q16[16];
#pragma unroll
        for (int rt = 0; rt < 4; ++rt) { const f32x4 eg = *(const LAS f32x4*)(ms + 16 * rt + 4 * g4), ek = *(const LAS f32x4*)(ms + 64 + 16 * rt + 4 * g4);
#pragma unroll
            for (int r = 0; r < 4; ++r) { const float o = eg[r] * oq[rt][r] + oa[rt][r]; oprev[rt][r] = o; q16[4 * rt + r] = o * o; }
            vn[rt] = vn[rt] * ek; }
        {
            float q8[8], q4[4], q2[2];
            const bool b0 = c15 & 1, b1 = c15 & 2, b2 = c15 & 4, b3 = c15 & 8;
#pragma unroll
            for (int k = 0; k < 8; ++k) { const float a = q16[2 * k], bb = q16[2 * k + 1]; q8[k] = (b0 ? bb : a) + sx<1>(b0 ? a : bb); }
#pragma unroll
            for (int k = 0; k < 4; ++k) { const float a = q8[2 * k], bb = q8[2 * k + 1]; q4[k] = (b1 ? bb : a) + sx<2>(b1 ? a : bb); }
#pragma unroll
            for (int k = 0; k < 2; ++k) { const float a = q4[2 * k], bb = q4[2 * k + 1]; q2[k] = (b2 ? bb : a) + sx<4>(b2 ? a : bb); }
            const float q1 = (b3 ? q2[1] : q2[0]) + sx<8>(b3 ? q2[0] : q2[1]);
            ((LAS float*)(lds + DN_SLOT))[(n & 1) * 512 + w * 64 + 16 * (c15 >> 2) + 4 * g4 + (c15 & 3)] = q1;
        }
#pragma unroll
        for (int k2 = 0; k2 < 2; ++k2) BV[k2] = pack8(vn[2 * k2], vn[2 * k2 + 1]);
        { bf16x8 kf[4][2];
#define DN_KF(dt, k2) join8(lds_tr16(lds + DN_K + (32 * (k2) + 4 * g4 + (c15 >> 2)) * DN_P + (16 * (dt) + 4 * (c15 & 3)) * 2), lds_tr16(lds + DN_K + (32 * (k2) + 4 * g4 + (c15 >> 2)) * DN_P + (16 * (dt) + 4 * (c15 & 3)) * 2 + 16 * DN_P))
#pragma unroll
          for (int hb = 0; hb < 2; ++hb) {
#pragma unroll
              for (int d4 = 0; d4 < 4; ++d4)
#pragma unroll
                  for (int k2 = 0; k2 < 2; ++k2) kf[d4][k2] = DN_KF(4 * hb + d4, k2);
              __builtin_amdgcn_sched_barrier(0);
#pragma unroll
              for (int d4 = 0; d4 < 4; ++d4) { f32x4 acc = S[4 * hb + d4] * cdec;
#pragma unroll
                  for (int k2 = 0; k2 < 2; ++k2) acc = mfma16(kf[d4][k2], BV[k2], acc);
                  S[4 * hb + d4] = acc; }
              __builtin_amdgcn_sched_barrier(0);
          }
#undef DN_KF
        }
    }
    __syncthreads();
    DN_RSTD((SEQ / 64 - 1) & 1);
    __syncthreads();
    DN_FINAL((SEQ / 64 - 1) & 1, SEQ / 64 - 1);
#undef DN_LOAD
#undef DN_APERM
#undef DN_RSTD
#undef DN_FINAL
    __syncthreads();
}

#define PHASE_BEGIN() unsigned char* wsl = ws; int bx = bx0; int G = G0; long zoff = 0; Ctx C = C0; asm volatile("" : "+s"(wsl), "+s"(bx), "+s"(G), "+s"(zoff), "+s"(C.wave), "+s"(C.gw), "+s"(C.NGW)); { unsigned zv = 0u; asm volatile("" : "+v"(zv)); C.lane = (int)__builtin_amdgcn_mbcnt_hi(~0u, __builtin_amdgcn_mbcnt_lo(~0u, zv)); } C.tid = C.wave * 64 + C.lane
#define INP(k) (a.in[k] + zoff)
#define MEMH ((bf16_t*)(wsl + WS_MEMH))
#define KVX ((bf16_t*)(wsl + WS_KX))
#define WinT ((bf16_t*)(wsl + WS_WIN))
#define WfT ((bf16_t*)(wsl + WS_WF))
#define WmoT ((bf16_t*)(wsl + WS_WMOT))
#define WpS ((bf16_t*)(wsl + WS_WPS))
#define WxqP ((bf16_t*)(wsl + WS_WXQ))
#define WxkvT ((bf16_t*)(wsl + WS_WXKV))
#define WxoT ((bf16_t*)(wsl + WS_WXO))
#define WguT ((bf16_t*)(wsl + WS_WGU))
#define WdT ((bf16_t*)(wsl + WS_WD))
#define LOGIT ((float*)(wsl + WS_LOGIT))
#define BETA ((float*)(wsl + WS_BETA))
#define GDEC ((float*)(wsl + WS_GDEC))
#define H ((bf16_t*)(wsl + WS_H))
#define AMIX ((bf16_t*)(wsl + WS_H))
#define PBUF ((bf16_t*)(wsl + WS_PBUF))
#define QKVN ((bf16_t*)(wsl + WS_QKVN))
#define SSQ ((float*)(wsl + WS_SSQ))
#define RSTD ((float*)(wsl + WS_RSTD))
#define XB ((bf16_t*)(wsl + WS_ODN))
#define WQK ((bf16_t*)(wsl + WS_WQK))
#define WOV ((bf16_t*)(wsl + WS_WOV))
#define PATT ((bf16_t*)(wsl + WS_PATT))
#define GB ((bf16_t*)(wsl + WS_G))
#define UB ((bf16_t*)(wsl + WS_U))
#define HALOG ((float*)(wsl + WS_HALO))
#define FIXG ((float*)(wsl + WS_FIXG))
#define FIXU ((float*)(wsl + WS_FIXU))

struct Args { const float* in[23]; float* out; unsigned char* ws; int l_lo, l_hi, ph_lo, ph_hi; int single, pad; };
constexpr int NPH = 18;

__global__ void __launch_bounds__(NTHR, 2) fwd_kernel(Args a) {
    extern __shared__ __attribute__((aligned(16))) unsigned char lds_raw[];
    LAS unsigned char* lds = (LAS unsigned char*)lds_raw;
    Ctx C0; C0.lds = lds; C0.tid = 0; C0.lane = 0; C0.wave = __builtin_amdgcn_readfirstlane(threadIdx.x >> 6);
    const int G0 = gridDim.x; const int bx0 = blockIdx.x; const int vcu = (G0 % 8 == 0) ? (bx0 % 8) * (G0 / 8) + bx0 / 8 : bx0;
    C0.gw = vcu * NWAVES + C0.wave; C0.NGW = G0 * NWAVES;
    unsigned char* ws = a.ws;
    unsigned* ctl = (unsigned*)(ws + WS_CTL);
    volatile LAS unsigned* MISC = (volatile LAS unsigned*)(lds + MISC_OFF);
    for (int u = threadIdx.x; u < (LDS_BYTES - LDSCTL_OFF) / 4; u += NTHR) ((LAS unsigned*)(lds + LDSCTL_OFF))[u] = 0u;
    __syncthreads();
    XcdBarrier bar; bar.bar = ctl + CW_BAR; bar.x = 0; bar.st = nullptr;
    if (a.single) bar = xcd_barrier_post(ctl + CW_BAR, MISC + 8);
#define SEAM() do { if (a.single) xcd_barrier(bar); } while (0)
#ifndef PH_MASK
#define PH_MASK 0x3ffff
#endif
#ifndef PROBE_MASK
#define PROBE_MASK 0
#endif
#define REPS(k) (1 + (((PROBE_MASK) >> (k)) & 1))
#define IN(k) ((((PH_MASK) >> (k)) & 1) && a.ph_lo <= (k) && (k) < a.ph_hi)


    for (int l = a.l_lo; l < a.l_hi; ++l) {

        if (IN(0)) for (int rep_ = 0; rep_ < REPS(0); ++rep_) { PHASE_BEGIN();
            LAS float* scr = (LAS float*)(lds + RING_OFF + C.wave * 16384);
            const float* w_in = INP(3) + (size_t)l * DM * INW; const float* w_mo = INP(10) + (size_t)l * DM * DM;
            const float* w_xq = INP(13) + (size_t)l * DM * DM; const float* w_xkv = INP(14) + (size_t)l * DM * 2 * DM; const float* w_xo = INP(15) + (size_t)l * DM * DM;
            const float* w_g = INP(17) + (size_t)l * DM * FF; const float* w_u = INP(18) + (size_t)l * DM * FF; const float* w_d = INP(21) + (size_t)l * FF * DM;
            constexpr int I_IN = (DM / 64) * ((INW + 63) / 64), I_MO1 = (1024 / 64) * (DM / 64), I_MO2 = I_MO1, I_XQ = (DM / 64) * (DM / 64), I_XKV = (DM / 64) * (2 * DM / 64), I_XO = I_XQ,
                          I_G = (DM / 64) * (FF / 64), I_U = I_G, I_D = (FF / 64) * (DM / 64);
            constexpr int NITEMS = I_IN + I_MO1 + I_MO2 + I_XKV + I_XO;
            for (int it = C.gw; it < NITEMS; it += C.NGW) {
                int r = it;
                if (r < I_IN) { transpose_item(w_in, DM, INW, INW, WinT, DM, scr, r, C.lane, 0, INP(2) + (size_t)l * DM); continue; } r -= I_IN;
                if (r < I_MO1) { transpose_item(w_mo, 1024, DM, DM, WmoT, 1024, scr, r, C.lane); continue; } r -= I_MO1;
                if (r < I_MO2) { transpose_item(w_mo + (size_t)1024 * DM, 1024, DM, DM, WfT + 1024, DM, scr, r, C.lane); continue; } r -= I_MO2;

                if (r < I_XKV) { transpose_item(w_xkv, DM, 2 * DM, 2 * DM, WxkvT, DM, scr, r, C.lane); continue; } r -= I_XKV;
                transpose_item(w_xo, DM, DM, DM, WxoT, DM, scr, r, C.lane);
            }
            {
                const float* g2 = INP(11) + (size_t)l * DM;
                for (size_t i = (size_t)(C.gw * 64 + C.lane) * 8; i < (size_t)DM * DM; i += (size_t)C.NGW * 64 * 8) { const f32x4 a = *(const f32x4*)(w_xq + i), bq = *(const f32x4*)(w_xq + i + 4); const float gg = g2[i >> 11];
                    u32x4 o; o.x = cvt_pk_bf16(a[0] * gg, a[1] * gg); o.y = cvt_pk_bf16(a[2] * gg, a[3] * gg); o.z = cvt_pk_bf16(bq[0] * gg, bq[1] * gg); o.w = cvt_pk_bf16(bq[2] * gg, bq[3] * gg); *(u32x4*)(WxqP + i) = o; }
            }
            {
                const float* wp = INP(4) + (size_t)l * 4 * 65536; const float* ps = INP(5) + (size_t)l * 1024;
                for (int i = (C.gw * 64 + C.lane) * 4; i < 4 * 65536; i += C.NGW * 64 * 4) {
                    const f32x4 w = *(const f32x4*)(wp + i); const int g = i >> 16, j = i & 255; const f32x4 s = *(const f32x4*)(ps + g * 256 + j);
                    u32x2 o; o.x = cvt_pk_bf16(w[0] * s[0], w[1] * s[1]); o.y = cvt_pk_bf16(w[2] * s[2], w[3] * s[3]); *(u32x2*)(WpS + i) = o; }
            }
            if (l == 0) rmsnorm_rows_first<false>(C, INP(1), INP(12), MEMH, MEMH, MM);
            if (l == 0) x_first(C, INP(0), XB, RSTD, M); else rstd_finish(C, SSQ, RSTD, M);
            SEAM();
        }
        if (IN(1)) for (int rep_ = 0; rep_ < REPS(1); ++rep_) { PHASE_BEGIN();
            { SchedP S{G, bx, (const char*)XB, (const char*)WinT, (char*)PBUF}; pg8::EpiP E{LOGIT, RSTD};
              pg8::gemm_phase<pg8::Gemm<DM, DM, DM>, pg8::EpiP, SchedP, true>(lds + RING_OFF, C.tid, S, E); }
            for (int blk = C.gw; blk < M / 16; blk += C.NGW) logits16(C.lane, XB, WinT + (size_t)PW * DM, RSTD, LOGIT, blk);
            SEAM();
        }
        if (IN(2)) for (int rep_ = 0; rep_ < REPS(2); ++rep_) { PHASE_BEGIN();
            const float* cw = INP(6) + (size_t)l * 4 * 3072;
#pragma unroll 1
            for (int task_ = C.gw; task_ < (M / 32) * 2; task_ += C.NGW) {
                const int task = (M / 32) * 2 - 1 - task_;
                const int run = task >> 1, sl = 6 + (task & 1), m0 = run * 32, t0 = m0 & (SEQ - 1);
                if (sl < 6) {
                    const int c0 = sl * 512 + C.lane * 8;
                    const GAS bf16_t* src = (const GAS bf16_t*)PBUF + (size_t)m0 * PW + 1024 + c0; GAS bf16_t* dst = (GAS bf16_t*)QKVN + (size_t)m0 * 3072 + c0;
                    float wk[4][8];
#pragma unroll
                    for (int k = 0; k < 4; ++k) { const f32x4 w0 = *(const f32x4*)(cw + k * 3072 + c0), w1 = *(const f32x4*)(cw + k * 3072 + c0 + 4);
                        wk[k][0] = w0[0]; wk[k][1] = w0[1]; wk[k][2] = w0[2]; wk[k][3] = w0[3]; wk[k][4] = w1[0]; wk[k][5] = w1[1]; wk[k][6] = w1[2]; wk[k][7] = w1[3]; }
                    u32x4 x1 = (u32x4){0u, 0u, 0u, 0u}, x2 = x1, x3 = x1;
                    if (t0 > 0) { x1 = *(const GAS u32x4*)(src - (size_t)PW); x2 = *(const GAS u32x4*)(src - (size_t)2 * PW); x3 = *(const GAS u32x4*)(src - (size_t)3 * PW); }
                    const float qsc = sl < 2 ? 0.08838834764831845f : 1.0f;
#pragma unroll 1
                    for (int tb = 0; tb < 32; tb += 4) {
                        u32x4 xn[4];
#pragma unroll
                        for (int i = 0; i < 4; ++i) xn[i] = *(const GAS u32x4*)(src + (size_t)(tb + i) * PW);
#pragma unroll
                        for (int i = 0; i < 4; ++i) {
                            const u32x4 x0 = xn[i]; float y[8];
                            const unsigned a0[4] = {x0.x, x0.y, x0.z, x0.w}, a1[4] = {x1.x, x1.y, x1.z, x1.w}, a2[4] = {x2.x, x2.y, x2.z, x2.w}, a3[4] = {x3.x, x3.y, x3.z, x3.w};
#pragma unroll
                            for (int e = 0; e < 4; ++e) {
                                y[2 * e] = wk[3][2 * e] * bflo(a0[e]) + wk[2][2 * e] * bflo(a1[e]) + wk[1][2 * e] * bflo(a2[e]) + wk[0][2 * e] * bflo(a3[e]);
                                y[2 * e + 1] = wk[3][2 * e + 1] * bfhi(a0[e]) + wk[2][2 * e + 1] * bfhi(a1[e]) + wk[1][2 * e + 1] * bfhi(a2[e]) + wk[0][2 * e + 1] * bfhi(a3[e]); }
                            float ss = 0.f;
#pragma unroll
                            for (int e = 0; e < 8; ++e) { y[e] = silu_f(y[e]); ss += y[e] * y[e]; }
                            float sc = 1.0f;
                            if (sl < 4) { ss += sx<1>(ss); ss += sx<2>(ss); ss += sx<4>(ss); ss += sx<8>(ss); sc = rsqrtf(ss + EPS) * qsc; }
                            u32x4 o; o.x = cvt_pk_bf16(y[0] * sc, y[1] * sc); o.y = cvt_pk_bf16(y[2] * sc, y[3] * sc); o.z = cvt_pk_bf16(y[4] * sc, y[5] * sc); o.w = cvt_pk_bf16(y[6] * sc, y[7] * sc);
                            *(GAS u32x4*)(dst + (size_t)(tb + i) * 3072) = o;
                            x3 = x2; x2 = x1; x1 = x0;
                        }
                    }
                } else {
                    const int c0 = (sl - 6) * 512 + C.lane * 8, w = 2 << (2 * (sl - 6) + (C.lane >> 5));
                    const GAS bf16_t* src = (const GAS bf16_t*)PBUF + (size_t)m0 * PW + c0; GAS bf16_t* dst = (GAS bf16_t*)AMIX + (size_t)m0 * DM + c0;
                    float S[8];
#pragma unroll
                    for (int e = 0; e < 8; ++e) S[e] = 0.f;
                    for (int i = 1; i <= 16; ++i) {
                        if (i <= w && t0 - i >= 0) { const u32x4 q = *(const GAS u32x4*)(src - (size_t)i * PW); const unsigned a[4] = {q.x, q.y, q.z, q.w};
#pragma unroll
                            for (int e = 0; e < 4; ++e) { S[2 * e] += bflo(a[e]); S[2 * e + 1] += bfhi(a[e]); } } }
#pragma unroll 1
                    for (int tb = 0; tb < 32; tb += 4) {
                        u32x4 xn[4], xl[4];
#pragma unroll
                        for (int i = 0; i < 4; ++i) { xn[i] = *(const GAS u32x4*)(src + (size_t)(tb + i) * PW);
                            xl[i] = (t0 + tb + i - w >= 0) ? *(const GAS u32x4*)(src + (size_t)(tb + i - w) * PW) : (u32x4){0u, 0u, 0u, 0u}; }
#pragma unroll
                        for (int i = 0; i < 4; ++i) {
                            const int t = t0 + tb + i; const float inv = 1.0f / (float)((t + 1) < w ? (t + 1) : w);
                            const unsigned a[4] = {xn[i].x, xn[i].y, xn[i].z, xn[i].w}, b[4] = {xl[i].x, xl[i].y, xl[i].z, xl[i].w}; unsigned o[4];
#pragma unroll
                            for (int e = 0; e < 4; ++e) { const float u0 = bflo(a[e]), u1 = bfhi(a[e]); S[2 * e] += u0 - bflo(b[e]); S[2 * e + 1] += u1 - bfhi(b[e]);
                                o[e] = cvt_pk_bf16(S[2 * e] * inv - u0, S[2 * e + 1] * inv - u1); }
                            *(GAS u32x4*)(dst + (size_t)(tb + i) * DM) = (u32x4){o[0], o[1], o[2], o[3]};
                        }
                    }
                }
            }
        }
        if (IN(3)) for (int rep_ = 0; rep_ < REPS(3); ++rep_) { PHASE_BEGIN();
#pragma unroll 1
            for (int task = C.gw; task < BATCH * 8 * (SEQ / 64); task += C.NGW) {
                const int h = task & 7, pr = task >> 3, b = pr >> 5, n = pr & 31;
                dn_conv_qkv(PBUF + (size_t)(b * SEQ + n * 64) * PW + 1024 + h * 128, INP(6) + (size_t)l * 4 * 3072 + h * 128, QKVN + (size_t)(b * SEQ + n * 64) * 3072 + h * 128, b * SEQ + n * 64);
                dn_chunk_prep(C.wave, (unsigned)(size_t)lds, QKVN, LOGIT, -__expf(INP(7)[l * 8 + h]), INP(8)[l * 8 + h], wsl + WS_REC + (size_t)((b * 8 + h) * 32 + n) * REC_BYTES, b * SEQ + n * 64, h);
            }
            {
                LAS float* scr = (LAS float*)(lds + C.wave * 17408);
                const float* w_g = INP(17) + (size_t)l * DM * FF; const float* w_u = INP(18) + (size_t)l * DM * FF; const float* w_d = INP(21) + (size_t)l * FF * DM;
                constexpr int I_G = (DM / 64) * (FF / 64), I_U = I_G, I_D = (FF / 64) * (DM / 64);
                for (int it = C.gw; it < I_G + I_U + I_D; it += C.NGW) {
                    int r = it;
                    if (r < I_G) { transpose_item(w_g, DM, FF, FF, WguT, DM, scr, r, C.lane, 1, INP(16) + (size_t)l * DM); continue; } r -= I_G;
                    if (r < I_U) { transpose_item(w_u, DM, FF, FF, WguT, DM, scr, r, C.lane, 2, INP(16) + (size_t)l * DM); continue; } r -= I_U;
                    transpose_item(w_d, FF, DM, DM, WdT, FF, scr, r, C.lane);
                }
            }
            SEAM();
        }
        if (IN(4)) for (int rep_ = 0; rep_ < REPS(4); ++rep_) { PHASE_BEGIN();
            if (G >= 2 * BATCH * 8 && bx >= BATCH * 8) {
                const int G2 = G - BATCH * 8, c2 = bx - BATCH * 8;
                { SchedWf S{G2, c2, (const char*)WmoT, (const char*)WpS, (char*)WfT}; pg8::EpiBf16 E;
                  pg8::gemm_phase<pg8::Gemm<1024, 256, 256>, pg8::EpiBf16, SchedWf, true>(lds + RING_OFF, C.tid, S, E); }
                { SchedKV S{G2, c2, (const char*)MEMH, (const char*)WxkvT, (char*)KVX}; pg8::EpiBf16 E;
                  pg8::gemm_phase<pg8::Gemm<DM, DM, DM>, pg8::EpiBf16, SchedKV, true>(lds + RING_OFF, C.tid, S, E); }
                sub_barrier(ctl + 16384, (unsigned)((l - a.l_lo + 1) * G2));
                { SchedQK S2{G2, c2, (const char*)KVX, (const char*)WxqP, (char*)WQK}; pg8::EpiBf16 E2;
                  pg8::gemm_phase<pg8::Gemm<4096, DM, 512>, pg8::EpiBf16, SchedQK, true>(lds + RING_OFF, C.tid, S2, E2); }
            } else {
#pragma unroll 1
                for (int bh = bx; bh < BATCH * 8; bh += G) dn_scan(C.tid, lds, QKVN, wsl + WS_REC, PBUF, AMIX, INP(9) + (size_t)l * 128, bh >> 3, bh & 7);
                if (G < 2 * BATCH * 8) {
                    { SchedWf S{G, bx, (const char*)WmoT, (const char*)WpS, (char*)WfT}; pg8::EpiBf16 E;
                      pg8::gemm_phase<pg8::Gemm<1024, 256, 256>, pg8::EpiBf16, SchedWf, true>(lds + RING_OFF, C.tid, S, E); }
                    { SchedKV S{G, bx, (const char*)MEMH, (const char*)WxkvT, (char*)KVX}; pg8::EpiBf16 E;
                      pg8::gemm_phase<pg8::Gemm<DM, DM, DM>, pg8::EpiBf16, SchedKV, true>(lds + RING_OFF, C.tid, S, E); }
                }
            }
            SEAM();
        }
        if (IN(6)) for (int rep_ = 0; rep_ < REPS(6); ++rep_) { PHASE_BEGIN();
            SchedX S{G, bx, (const char*)AMIX, (const char*)WfT, (char*)XB}; pg8::EpiResid E{XB, XB, SSQ};
            pg8::gemm_phase<pg8::Gemm<DM, DM, DM>, pg8::EpiResid, SchedX, true>(lds + RING_OFF, C.tid, S, E);
            if (G < 2 * BATCH * 8) { SchedQK S2{G, bx, (const char*)KVX, (const char*)WxqP, (char*)WQK}; pg8::EpiBf16 E2;
              pg8::gemm_phase<pg8::Gemm<4096, DM, 512>, pg8::EpiBf16, SchedQK, true>(lds + RING_OFF, C.tid, S2, E2); }
            { SchedOV S3{G, bx, (const char*)WxoT, (const char*)KVX, (char*)WOV}; pg8::EpiBf16 E3;
              pg8::gemm_phase<pg8::Gemm<DM, 4096, 512>, pg8::EpiBf16, SchedOV, true>(lds + RING_OFF, C.tid, S3, E3); }
            SEAM();
        }
        if (IN(7)) for (int rep_ = 0; rep_ < REPS(7); ++rep_) { PHASE_BEGIN(); rstd_finish(C, SSQ, RSTD, M); SEAM(); }
        if (IN(9)) for (int rep_ = 0; rep_ < REPS(9); ++rep_) { PHASE_BEGIN();
            SchedS S{G, bx, (const char*)XB, (const char*)WQK, (char*)PATT}; pg8::EpiSoftmax E{0.04419417382415922f, (LAS float*)(lds + RING_BYTES), RSTD};
            pg8::gemm_phase<pg8::Gemm<DM, DM, DM>, pg8::EpiSoftmax, SchedS, true>(lds + RING_OFF, C.tid, S, E);
            SEAM();
        }
        if (IN(12)) for (int rep_ = 0; rep_ < REPS(12); ++rep_) { PHASE_BEGIN();
            SchedXO S{G, bx, (const char*)PATT, (const char*)WOV}; pg8::EpiResid E{XB, XB, SSQ};
            pg8::gemm_phase<pg8::Gemm<1024, 1024, 1024>, pg8::EpiResid, SchedXO, true>(lds + RING_OFF, C.tid, S, E);
            SEAM();
        }
        if (IN(13)) for (int rep_ = 0; rep_ < REPS(13); ++rep_) { PHASE_BEGIN(); rstd_finish(C, SSQ, RSTD, M); SEAM(); }
        if (IN(14)) for (int rep_ = 0; rep_ < REPS(14); ++rep_) { PHASE_BEGIN();
            SchedGU S{G, bx, (const char*)XB, (const char*)WguT, (char*)GB, (char*)UB};
            pg8::EpiGLU E{INP(19) + (size_t)l * 3 * FF, INP(20) + (size_t)l * FF, GB, HALOG, FIXG, FIXU, (LAS float*)(lds + RING_BYTES), RSTD};
            pg8::gemm_phase<pg8::Gemm<DM, DM, DM>, pg8::EpiGLU, SchedGU, true>(lds + RING_OFF, C.tid, S, E);
            SEAM();
        }
        if (IN(15)) for (int rep_ = 0; rep_ < REPS(15); ++rep_) { PHASE_BEGIN();
            const float* cw = INP(19) + (size_t)l * 3 * FF; const float* cb = INP(20) + (size_t)l * FF;
            for (int i = C.gw * 64 + C.lane; i < (M / 256) * 2 * (FF / 4); i += C.NGW * 64) {
                const int c4 = (i % (FF / 4)) * 4, pr = i / (FF / 4), pm = pr >> 1, r = pr & 1;
                if ((pm & 7) == 0) continue;
                const f32x4 g0 = *(const f32x4*)(FIXG + (size_t)(pm * 2 + r) * FF + c4), up = *(const f32x4*)(FIXU + (size_t)(pm * 2 + r) * FF + c4);
                const f32x4 hl1 = *(const f32x4*)(HALOG + (size_t)((pm - 1) * 2 + 1) * FF + c4);
                const f32x4 g1 = r ? *(const f32x4*)(FIXG + (size_t)(pm * 2) * FF + c4) : hl1;
                const f32x4 g2 = r ? hl1 : *(const f32x4*)(HALOG + (size_t)((pm - 1) * 2) * FF + c4);
                const f32x4 w0 = *(const f32x4*)(cw + c4), w1 = *(const f32x4*)(cw + FF + c4), w2 = *(const f32x4*)(cw + 2 * FF + c4), bb = *(const f32x4*)(cb + c4);
                float hv[4];
#pragma unroll
                for (int j = 0; j < 4; ++j) hv[j] = silu_f(bb[j] + w2[j] * g0[j] + w1[j] * g1[j] + w0[j] * g2[j]) * (up[j] * -1.4426950408889634f);
                u32x2 o; o.x = cvt_pk_bf16(hv[0], hv[1]); o.y = cvt_pk_bf16(hv[2], hv[3]);
                *(u32x2*)(GB + (size_t)(pm * 256 + r) * FF + c4) = o;
            }
            SEAM();
        }
        if (IN(16)) for (int rep_ = 0; rep_ < REPS(16); ++rep_) { PHASE_BEGIN();
            SchedD S{G, bx, (const char*)GB, (const char*)WdT, (char*)XB}; pg8::EpiResid E{XB, XB, SSQ};
            pg8::gemm_phase<pg8::Gemm<FF, FF, FF>, pg8::EpiResid, SchedD, true>(lds + RING_OFF, C.tid, S, E);
            if (l != DEPTH - 1 || IN(17)) SEAM();
        }
        if (IN(17) && l == DEPTH - 1) { PHASE_BEGIN(); (void)wsl; (void)bx; (void)G; rmsnorm_rows_f32(C, XB, a.out + zoff, INP(22), M); }
    }
#undef SEAM
#undef IN
}

extern "C" void kernel_launch(void* const* d_in, const int* in_sizes, int n_in, void* d_out, int out_size, void* d_ws, size_t ws_size, hipStream_t stream) {
    static int grid = 0;
    if (grid == 0) {
        if (n_in != 23 || in_sizes[0] != M * DM || out_size != M * DM || ws_size < WS_END) { fprintf(stderr, "kernel_launch: unexpected shapes (n_in %d, in0 %d, out %d, ws %zu)\n", n_in, n_in > 0 ? in_sizes[0] : -1, out_size, ws_size); grid = -1; return; }
        int dev = 0, cus = 0, per_cu = 0;
        if (hipGetDevice(&dev) != hipSuccess || hipDeviceGetAttribute(&cus, hipDeviceAttributeMultiprocessorCount, dev) != hipSuccess) { grid = -1; return; }
        if (hipFuncSetAttribute((const void*)fwd_kernel, hipFuncAttributeMaxDynamicSharedMemorySize, LDS_BYTES) != hipSuccess) { fprintf(stderr, "kernel_launch: hipFuncSetAttribute failed\n"); grid = -1; return; }
        if (hipOccupancyMaxActiveBlocksPerMultiprocessor(&per_cu, (const void*)fwd_kernel, NTHR, LDS_BYTES) != hipSuccess || per_cu < 1) fprintf(stderr, "kernel_launch: occupancy query says %d\n", per_cu);
        (void)hipGetLastError();
        grid = cus;
    }
    if (grid < 0) return;
    if (hipMemsetAsync((char*)d_ws + WS_CTL, 0, CTL_ZERO_BYTES, stream) != hipSuccess) return;
    Args a{};
    for (int i = 0; i < 23; ++i) a.in[i] = (const float*)d_in[i];
    a.out = (float*)d_out; a.ws = (unsigned char*)d_ws; a.pad = 0;
#if ONE_LAUNCH
    a.l_lo = 0; a.l_hi = DEPTH; a.ph_lo = 0; a.ph_hi = NPH; a.single = 1;
    hipLaunchKernelGGL(fwd_kernel, dim3(grid), dim3(NTHR), LDS_BYTES, stream, a);
#else
    a.single = 0;
    for (int l = 0; l < DEPTH; ++l)
        for (int p = 0; p < NPH; ++p) {
            if (p == NPH - 1 && l != DEPTH - 1) continue;
            a.l_lo = l; a.l_hi = l + 1; a.ph_lo = p; a.ph_hi = p + 1;
            hipLaunchKernelGGL(fwd_kernel, dim3(grid), dim3(NTHR), LDS_BYTES, stream, a);
        }
#endif
}
```
